# Optimizing an MI355X kernel written in HIP

```python
import jax, jax.numpy as jnp
from jax import lax
import numpy as np

D_MODEL = 1024
BATCH = 16
SEQ = 4096
DEPTH = 2

CHUNK = 64
HEAD_DIM = 64
ROT_DIM = HEAD_DIM // 4
ROPE_THETA = 500000.0
RMS_EPS = 1e-6
LN_EPS = 1e-6
NEG_INF = -1e30

FOX_HEADS = 8
FOX_WIDTH = FOX_HEADS * HEAD_DIM
FOX_BLOCK = 128
DSA_HEADS = 8
DSA_WIDTH = DSA_HEADS * HEAD_DIM
IDX_HEADS = 8
IDX_DIM = 64
DSA_TOPK = 256
DSA_BLOCK = 64
FOX_SPLITS = (FOX_WIDTH, FOX_WIDTH, FOX_WIDTH, FOX_HEADS, FOX_WIDTH)
DSA_SPLITS = (DSA_WIDTH, DSA_WIDTH, DSA_WIDTH, IDX_HEADS * IDX_DIM, IDX_DIM, IDX_HEADS, DSA_WIDTH)
IN0_DIM = sum(FOX_SPLITS) + sum(DSA_SPLITS)
MIX0_WIDTH = FOX_WIDTH + DSA_WIDTH

CHK_HEADS = 16
CHK_WIDTH = CHK_HEADS * HEAD_DIM
CHK_LEFT_CHUNKS = 8
MAX_REL_DIST = 128
CHK_SPLITS = (CHK_WIDTH, CHK_WIDTH, CHK_WIDTH, CHK_WIDTH)
IN1_DIM = sum(CHK_SPLITS)

kernel_name = "hybrid_fox_dsa_chunkattn_sandwich"


def rms_norm(x, g):
    xf = x.astype(jnp.float32)
    y = xf * lax.rsqrt(jnp.mean(xf * xf, axis=-1, keepdims=True) + RMS_EPS)
    return (y * g.astype(jnp.float32)).astype(x.dtype)


def layer_norm(x, g, b):
    xf = x.astype(jnp.float32)
    mu = jnp.mean(xf, axis=-1, keepdims=True)
    xc = xf - mu
    y = xc * lax.rsqrt(jnp.mean(xc * xc, axis=-1, keepdims=True) + LN_EPS)
    return (y * g.astype(jnp.float32) + b.astype(jnp.float32)).astype(x.dtype)


def take_cols(h, sizes):
    out, off = [], 0
    for n in sizes:
        out.append(h[..., off:off + n])
        off += n
    return out


def to_heads(t, n_heads):
    return t.reshape(t.shape[0], t.shape[1], n_heads, HEAD_DIM)


def rope_tables(positions):
    inv_freq = ROPE_THETA ** (-jnp.arange(0, ROT_DIM, 2, dtype=jnp.float32) / ROT_DIM)
    ang = positions.astype(jnp.float32)[..., None] * inv_freq
    return jnp.cos(ang), jnp.sin(ang)


def apply_partial_rope(t, cos, sin):
    half = ROT_DIM // 2
    c = cos[:, :, None, :].astype(t.dtype)
    s = sin[:, :, None, :].astype(t.dtype)
    t1, t2, tp = t[..., :half], t[..., half:ROT_DIM], t[..., ROT_DIM:]
    return jnp.concatenate([t1 * c - t2 * s, t2 * c + t1 * s, tp], axis=-1)


def forgetting_attention(q, k, v, f_logit):
    B, S, H, D = q.shape
    F = jnp.cumsum(jax.nn.log_sigmoid(f_logit.astype(jnp.float32)), axis=1)
    Fh = F.transpose(0, 2, 1)
    scale = D ** -0.5
    key_pos = jnp.arange(S)

    def block(i):
        start = i * FOX_BLOCK
        qb = lax.dynamic_slice_in_dim(q, start, FOX_BLOCK, axis=1)
        Fq = lax.dynamic_slice_in_dim(Fh, start, FOX_BLOCK, axis=2)
        s = jnp.einsum('bqhd,bkhd->bhqk', qb, k, preferred_element_type=jnp.float32) * scale
        s = s + Fq[..., None] - Fh[:, :, None, :]
        q_pos = start + jnp.arange(FOX_BLOCK)
        causal = key_pos[None, :] <= q_pos[:, None]
        s = jnp.where(causal[None, None], s, NEG_INF)
        p = jax.nn.softmax(s, axis=-1)
        return jnp.einsum('bhqk,bkhd->bqhd', p.astype(v.dtype), v)

    out = lax.map(block, jnp.arange(S // FOX_BLOCK))
    return out.transpose(1, 0, 2, 3, 4).reshape(B, S, H * D)


def dsa_attention(q, k, v, iq, ik, iw, top_k):
    B, S, H, D = q.shape
    scale = D ** -0.5
    idx_scale = (IDX_HEADS * IDX_DIM) ** -0.5
    key_pos = jnp.arange(S)

    def block(i):
        start = i * DSA_BLOCK
        qb = lax.dynamic_slice_in_dim(q, start, DSA_BLOCK, axis=1)
        iqb = lax.dynamic_slice_in_dim(iq, start, DSA_BLOCK, axis=1)
        iwb = lax.dynamic_slice_in_dim(iw, start, DSA_BLOCK, axis=1)
        q_pos = start + jnp.arange(DSA_BLOCK)
        limit = (q_pos // CHUNK + 1) * CHUNK
        admissible = key_pos[None, :] < limit[:, None]
        rel = jax.nn.relu(jnp.einsum('bqhd,bkd->bqhk', iqb, ik, preferred_element_type=jnp.float32))
        score = jnp.einsum('bqhk,bqh->bqk', rel, iwb.astype(jnp.float32)) * idx_scale
        score = jnp.where(admissible[None], score, NEG_INF)
        _, sel = lax.top_k(score, top_k)
        ksel = jax.vmap(lambda kb, ib: kb[ib])(k, sel)
        vsel = jax.vmap(lambda vb, ib: vb[ib])(v, sel)
        s = jnp.einsum('bqhd,bqkhd->bhqk', qb, ksel, preferred_element_type=jnp.float32) * scale
        ok = sel < limit[None, :, None]
        s = jnp.where(ok[:, None], s, NEG_INF)
        p = jax.nn.softmax(s, axis=-1)
        return jnp.einsum('bhqk,bqkhd->bqhd', p.astype(v.dtype), vsel)

    out = lax.map(block, jnp.arange(S // DSA_BLOCK))
    return out.transpose(1, 0, 2, 3, 4).reshape(B, S, H * D)


def chunk_band_attention(q, k, v, rel_table):
    B, S, H, D = q.shape
    scale = D ** -0.5
    left = CHK_LEFT_CHUNKS * CHUNK
    band = left + CHUNK
    kp = jnp.pad(k, ((0, 0), (left, 0), (0, 0), (0, 0)))
    vp = jnp.pad(v, ((0, 0), (left, 0), (0, 0), (0, 0)))
    i = jnp.arange(CHUNK)
    j = jnp.arange(band)
    dist = i[:, None] - j[None, :] + left
    bucket = jnp.clip(dist, -MAX_REL_DIST, MAX_REL_DIST) + MAX_REL_DIST
    bias = rel_table[:, bucket].astype(jnp.float32)

    def block(c):
        start = c * CHUNK
        qb = lax.dynamic_slice_in_dim(q, start, CHUNK, axis=1)
        kb = lax.dynamic_slice_in_dim(kp, start, band, axis=1)
        vb = lax.dynamic_slice_in_dim(vp, start, band, axis=1)
        s = jnp.einsum('bqhd,bkhd->bhqk', qb, kb, preferred_element_type=jnp.float32) * scale
        s = s + bias[None]
        valid = j >= left - start
        s = jnp.where(valid[None, None, None, :], s, NEG_INF)
        p = jax.nn.softmax(s, axis=-1)
        return jnp.einsum('bhqk,bkhd->bqhd', p.astype(vb.dtype), vb)

    out = lax.map(block, jnp.arange(S // CHUNK))
    return out.transpose(1, 0, 2, 3, 4).reshape(B, S, H * D)


def even_layer(x, cos, sin, pre_g, post_g, w_in, b_forget, idx_k_g, idx_k_b, w_out, top_k):
    B, S, _ = x.shape
    h = rms_norm(x, pre_g)
    proj = jnp.einsum('bsd,de->bse', h, w_in)
    fq, fk, fv, f_logit, f_gate, dq, dk, dv, iq, ik, iw, d_gate = take_cols(proj, FOX_SPLITS + DSA_SPLITS)
    fox = forgetting_attention(to_heads(fq, FOX_HEADS), to_heads(fk, FOX_HEADS),
                               to_heads(fv, FOX_HEADS), f_logit + b_forget)
    fox = fox * jax.nn.silu(f_gate)
    dq = apply_partial_rope(to_heads(dq, DSA_HEADS), cos, sin)
    dk = apply_partial_rope(to_heads(dk, DSA_HEADS), cos, sin)
    dv = to_heads(dv, DSA_HEADS)
    iq = apply_partial_rope(iq.reshape(B, S, IDX_HEADS, IDX_DIM), cos, sin)
    ik = apply_partial_rope(layer_norm(ik, idx_k_g, idx_k_b)[:, :, None, :], cos, sin)[:, :, 0, :]
    dsa = dsa_attention(dq, dk, dv, iq, ik, iw, top_k) * jax.nn.silu(d_gate)
    y = jnp.einsum('bse,ed->bsd', jnp.concatenate([fox, dsa], axis=-1), w_out)
    return x + rms_norm(y, post_g)


def odd_layer(x, pre_g, post_g, w_in, rel_table, w_out):
    h = rms_norm(x, pre_g)
    proj = jnp.einsum('bsd,de->bse', h, w_in)
    cq, ck, cv, c_gate = take_cols(proj, CHK_SPLITS)
    att = chunk_band_attention(to_heads(cq, CHK_HEADS), to_heads(ck, CHK_HEADS),
                               to_heads(cv, CHK_HEADS), rel_table)
    y = jnp.einsum('bse,ed->bsd', att * jax.nn.silu(c_gate), w_out)
    return x + rms_norm(y, post_g)


def setup_inputs(seed: int = 0) -> dict:
    key = jax.random.key(seed)
    ks = jax.random.split(key, 12)
    n_even = (DEPTH + 1) // 2
    n_odd = DEPTH // 2
    f32 = jnp.float32
    x = jax.random.normal(ks[0], (BATCH, SEQ, D_MODEL), f32)
    positions = jnp.broadcast_to(jnp.arange(SEQ, dtype=jnp.int32), (BATCH, SEQ))
    pre_norm_g = 1.0 + 0.05 * jax.random.normal(ks[1], (DEPTH, D_MODEL), f32)
    post_norm_g = 1.0 + 0.05 * jax.random.normal(ks[2], (DEPTH, D_MODEL), f32)
    w_in_even = jax.random.normal(ks[3], (n_even, D_MODEL, IN0_DIM), f32) * D_MODEL ** -0.5
    b_forget = jax.random.uniform(ks[4], (n_even, FOX_HEADS), f32, minval=1.0, maxval=5.0)
    idx_k_g = 1.0 + 0.05 * jax.random.normal(ks[5], (n_even, IDX_DIM), f32)
    idx_k_b = 0.02 * jax.random.normal(ks[6], (n_even, IDX_DIM), f32)
    w_out_even = jax.random.normal(ks[7], (n_even, MIX0_WIDTH, D_MODEL), f32) * MIX0_WIDTH ** -0.5
    w_in_odd = jax.random.normal(ks[8], (n_odd, D_MODEL, IN1_DIM), f32) * D_MODEL ** -0.5
    rel_bias = 0.5 * jax.random.normal(ks[9], (n_odd, CHK_HEADS, 2 * MAX_REL_DIST + 1), f32)
    w_out_odd = jax.random.normal(ks[10], (n_odd, CHK_WIDTH, D_MODEL), f32) * CHK_WIDTH ** -0.5
    return {"x": x, "positions": positions, "pre_norm_g": pre_norm_g, "post_norm_g": post_norm_g,
            "w_in_even": w_in_even, "b_forget": b_forget, "idx_k_g": idx_k_g, "idx_k_b": idx_k_b,
            "w_out_even": w_out_even, "w_in_odd": w_in_odd, "rel_bias": rel_bias, "w_out_odd": w_out_odd}


def reference(x, positions, pre_norm_g, post_norm_g, w_in_even, b_forget, idx_k_g, idx_k_b,
              w_out_even, w_in_odd, rel_bias, w_out_odd):
    seq = x.shape[1]
    top_k = min(DSA_TOPK, seq // 4)
    cos, sin = rope_tables(positions)
    for layer in range(DEPTH):
        if layer % 2 == 0:
            e = layer // 2
            x = even_layer(x, cos, sin, pre_norm_g[layer], post_norm_g[layer], w_in_even[e],
                           b_forget[e], idx_k_g[e], idx_k_b[e], w_out_even[e], top_k)
        else:
            o = layer // 2
            x = odd_layer(x, pre_norm_g[layer], post_norm_g[layer], w_in_odd[o], rel_bias[o], w_out_odd[o])
    return x
```

```cpp
#include <hip/hip_runtime.h>
#include <cstdio>
#include <cstdint>
#include <cmath>

#define GAS __attribute__((address_space(1)))
#define LAS __attribute__((address_space(3)))
typedef unsigned short bf16;
typedef short bf16x8 __attribute__((ext_vector_type(8)));
typedef short s16x4 __attribute__((ext_vector_type(4)));
typedef float f32x4 __attribute__((ext_vector_type(4)));
typedef float f32x16 __attribute__((ext_vector_type(16)));
typedef unsigned u32x4 __attribute__((ext_vector_type(4)));
typedef unsigned u32x2 __attribute__((ext_vector_type(2)));

constexpr int NB = 16, SEQ = 4096, DM = 1024, M = NB * SEQ;
constexpr int N0 = 4864;
constexpr int N1 = 4096;
constexpr float LOG2E = 1.4426950408889634f;
constexpr float C2 = 0.125f * LOG2E;
constexpr float RMS_EPS = 1e-6f, LN_EPS = 1e-6f;
constexpr float IDX_SCALE = 0.04419417382415922f;
constexpr int TOPK = 256;
constexpr int NWAVES = 8, NTHR = 512;

constexpr size_t MiB = 1u << 20;
constexpr size_t WS_CTL = 0, CTL_ZERO_BYTES = 1 * MiB;
constexpr size_t WS_W0T = 1 * MiB;
constexpr size_t WS_WO0T = 11 * MiB;
constexpr size_t WS_W1T = 13 * MiB;
constexpr size_t WS_WO1T = 21 * MiB;
constexpr size_t WS_FLG = 23 * MiB;
constexpr size_t WS_IW = 25 * MiB;
constexpr size_t WS_IKRAW = 27 * MiB;
constexpr size_t WS_IK = 43 * MiB;
constexpr size_t WS_FL = 51 * MiB;
constexpr size_t WS_COS = 53 * MiB;
constexpr size_t WS_SIN = 55 * MiB;
constexpr size_t WS_MASK = 57 * MiB;
constexpr size_t WS_H = 96 * MiB;
constexpr size_t WS_QQ = 224 * MiB;
constexpr size_t WS_KK = 352 * MiB;
constexpr size_t WS_VV = 480 * MiB;
constexpr size_t WS_GG = 608 * MiB;
constexpr size_t WS_IQ = 736 * MiB;
constexpr size_t WS_Y = 800 * MiB;
constexpr size_t WS_END = 928 * MiB;
static_assert(WS_MASK + (size_t)M * 512 <= WS_H && WS_IQ + (size_t)M * 1024 <= WS_Y, "ws map");

constexpr int LDS_BYTES = 147456;
constexpr int MISC_OFF = LDS_BYTES - 256;

struct Prm {
    const float* x; const int* pos; const float* pre_g; const float* post_g; const float* w_in0; const float* b_forget; const float* ikg; const float* ikb;
    const float* w_out0; const float* w_in1; const float* rel; const float* w_out1;
    float* out; unsigned char* ws;
    int ph_lo, ph_hi;
};

__device__ __forceinline__ int crow(int r, int hi) { return (r & 3) + 8 * (r >> 2) + 4 * hi; }
__device__ __forceinline__ unsigned f2bf(float f) { unsigned u = __builtin_bit_cast(unsigned, f); return (u + 0x7fffu + ((u >> 16) & 1u)) >> 16; }
__device__ __forceinline__ float bf2f(unsigned h) { return __builtin_bit_cast(float, h << 16); }
__device__ __forceinline__ unsigned pk2(float lo, float hi) { return f2bf(lo) | (f2bf(hi) << 16); }
__device__ __forceinline__ float wave_sum(float v) {
#pragma unroll
    for (int o = 1; o < 64; o <<= 1) v += __shfl_xor(v, o);
    return v;
}
__device__ __forceinline__ float silu(float g) { return g / (1.f + __expf(-g)); }

__device__ __forceinline__ int w0_src_col(int n) {
    if (n < 4096) { const int seg = n >> 9, off = n & 511;
        const int base = seg == 0 ? 0 : seg == 1 ? 2056 : seg == 2 ? 512 : seg == 3 ? 2568 : seg == 4 ? 1024 : seg == 5 ? 3080 : seg == 6 ? 1544 : 4176;
        return base + off; }
    if (n < 4608) return 3592 + (n - 4096);
    if (n < 4672) return 4104 + (n - 4608);
    if (n < 4680) return 1536 + (n - 4672);
    if (n < 4688) return 4168 + (n - 4680);
    return -1;
}
template <bool MAP0>
__device__ __forceinline__ void transpose_item(const float* W, int Nsrc, int Ndst, bf16* WT, LAS float* scr, int item, int lane) {
    const int nblk = Ndst / 32, kb = item / nblk, nb = item % nblk, k0 = 64 * kb, n0 = 32 * nb;
    const int nd = n0 + (lane & 31); const int ns = MAP0 ? w0_src_col(nd) : nd;
#pragma unroll 8
    for (int i = 0; i < 32; ++i) { const int kk = 2 * i + (lane >> 5); scr[kk * 33 + (lane & 31)] = ns >= 0 ? W[(size_t)(k0 + kk) * Nsrc + ns] : 0.f; }
    asm volatile("s_waitcnt lgkmcnt(0)" ::: "memory");
    const int c = lane & 7;
#pragma unroll
    for (int j = 0; j < 4; ++j) { const int n = (lane >> 3) + 8 * j; const LAS float* s = scr + (8 * c) * 33 + n;
        u32x4 o; o.x = pk2(s[0 * 33], s[1 * 33]); o.y = pk2(s[2 * 33], s[3 * 33]); o.z = pk2(s[4 * 33], s[5 * 33]); o.w = pk2(s[6 * 33], s[7 * 33]);
        *(u32x4*)(WT + (size_t)(n0 + n) * 1024 + k0 + 8 * c) = o; }
    asm volatile("s_waitcnt lgkmcnt(0)" ::: "memory");
}
__device__ __forceinline__ void rms_row_to_bf16(const float* src, const float* g, bf16* dst, int lane) {
    const f32x4* xr = (const f32x4*)src + lane; const f32x4* gr = (const f32x4*)g + lane;
    f32x4 v[4]; float s = 0.f;
#pragma unroll
    for (int j = 0; j < 4; ++j) { v[j] = xr[64 * j]; s += (v[j].x * v[j].x + v[j].y * v[j].y) + (v[j].z * v[j].z + v[j].w * v[j].w); }
    const float rs = 1.0f / sqrtf(wave_sum(s) * (1.f / DM) + RMS_EPS);
    unsigned long long* o8 = (unsigned long long*)dst + lane;
#pragma unroll
    for (int j = 0; j < 4; ++j) { const f32x4 gg = gr[64 * j];
        o8[64 * j] = (unsigned long long)pk2(v[j].x * rs * gg.x, v[j].y * rs * gg.y) | ((unsigned long long)pk2(v[j].z * rs * gg.z, v[j].w * rs * gg.w) << 32); }
}
__device__ __forceinline__ void p0_prologue(const Prm& P, LAS unsigned char* lds, int vcu, int G) {
    const int tid = threadIdx.x, lane = tid & 63, wave = tid >> 6;
    LAS float* scr = (LAS float*)(lds + wave * 16384);
    const int gw = vcu * NWAVES + wave, NGW = G * NWAVES;
    unsigned char* ws = P.ws;
    constexpr int I0 = 16 * (N0 / 32), IO = 16 * 32, I1 = 16 * (N1 / 32);
    constexpr int NIT = I0 + IO + I1 + IO;
    for (int it = gw; it < NIT; it += NGW) {
        int r = it;
        if (r < I0) { transpose_item<true>(P.w_in0, 4688, N0, (bf16*)(ws + WS_W0T), scr, r, lane); continue; } r -= I0;
        if (r < IO) { transpose_item<false>(P.w_out0, 1024, 1024, (bf16*)(ws + WS_WO0T), scr, r, lane); continue; } r -= IO;
        if (r < I1) { transpose_item<false>(P.w_in1, N1, N1, (bf16*)(ws + WS_W1T), scr, r, lane); continue; } r -= I1;
        transpose_item<false>(P.w_out1, 1024, 1024, (bf16*)(ws + WS_WO1T), scr, r, lane);
    }
    bf16* H = (bf16*)(ws + WS_H);
    for (int m = gw; m < M; m += NGW) rms_row_to_bf16(P.x + (size_t)m * DM, P.pre_g, H + (size_t)m * DM, lane);
    float* COS = (float*)(ws + WS_COS); float* SIN = (float*)(ws + WS_SIN);
    for (int idx = vcu * NTHR + tid; idx < M * 8; idx += G * NTHR) {
        const int m = idx >> 3, j = idx & 7;
        const float inv_freq = powf(500000.0f, -(float)j * 0.125f);
        const float ang = (float)P.pos[m] * inv_freq;
        COS[idx] = cosf(ang); SIN[idx] = sinf(ang);
    }
}

template <class Epi>
__device__ __forceinline__ void gemm_simple(const bf16* __restrict__ A, const bf16* __restrict__ Bt, int N, const Epi& E, int vcu, int G) {
    const int tid = threadIdx.x, lane = tid & 63, wid = tid >> 6, r32 = lane & 31, hi = lane >> 5, wr = wid >> 1, wc = wid & 1;
    constexpr int K = 1024;
    const int nN = N / 256, nun = (M / 256) * nN;
    for (int u = vcu; u < nun; u += G) {
        const int pm = u / nN, pn = u % nN;
        f32x16 acc[2][4];
#pragma unroll
        for (int i = 0; i < 2; ++i)
#pragma unroll
            for (int j = 0; j < 4; ++j) acc[i][j] = f32x16{};
        const bf16* a0 = A + (size_t)(pm * 256 + wr * 64 + r32) * K + hi * 8;
        const bf16* b0 = Bt + (size_t)(pn * 256 + wc * 128 + r32) * K + hi * 8;
#pragma unroll 2
        for (int k = 0; k < K; k += 16) {
            bf16x8 af[2], bfr[4];
#pragma unroll
            for (int i = 0; i < 2; ++i) af[i] = *(const bf16x8*)(a0 + (size_t)i * 32 * K + k);
#pragma unroll
            for (int j = 0; j < 4; ++j) bfr[j] = *(const bf16x8*)(b0 + (size_t)j * 32 * K + k);
#pragma unroll
            for (int i = 0; i < 2; ++i)
#pragma unroll
                for (int j = 0; j < 4; ++j) acc[i][j] = __builtin_amdgcn_mfma_f32_32x32x16_bf16(af[i], bfr[j], acc[i][j], 0, 0, 0);
        }
#pragma unroll
        for (int i = 0; i < 2; ++i)
#pragma unroll
            for (int j = 0; j < 4; ++j)
#pragma unroll
                for (int r = 0; r < 16; ++r) E(pm * 256 + wr * 64 + i * 32 + crow(r, hi), pn * 256 + wc * 128 + j * 32 + r32, acc[i][j][r]);
    }
}
struct EpiProj0 {
    unsigned char* ws;
    __device__ __forceinline__ void operator()(int row, int col, float v) const {
        if (col < 4096) { const int t = col >> 10; if (t == 0) v *= C2;
            ((bf16*)(ws + WS_QQ + (size_t)t * (WS_KK - WS_QQ)))[(size_t)row * 1024 + (col & 1023)] = (bf16)f2bf(v); }
        else if (col < 4608) ((bf16*)(ws + WS_IQ))[(size_t)row * 512 + (col - 4096)] = (bf16)f2bf(v);
        else if (col < 4672) ((float*)(ws + WS_IKRAW))[(size_t)row * 64 + (col - 4608)] = v;
        else if (col < 4680) ((float*)(ws + WS_FLG))[(size_t)row * 8 + (col - 4672)] = v;
        else if (col < 4688) ((float*)(ws + WS_IW))[(size_t)row * 8 + (col - 4680)] = v;
    }
};
struct EpiProj1 {
    unsigned char* ws;
    __device__ __forceinline__ void operator()(int row, int col, float v) const {
        const int t = col >> 10; if (t == 0) v *= C2;
        ((bf16*)(ws + WS_QQ + (size_t)t * (WS_KK - WS_QQ)))[(size_t)row * 1024 + (col & 1023)] = (bf16)f2bf(v);
    }
};
struct EpiY {
    bf16* Y;
    __device__ __forceinline__ void operator()(int row, int col, float v) const { Y[(size_t)row * 1024 + col] = (bf16)f2bf(v); }
};

__device__ __forceinline__ float log_sigmoid(float v) { return fminf(v, 0.f) - log1pf(expf(-fabsf(v))); }
__device__ __forceinline__ void p2_post(const Prm& P, int vcu, int G) {
    const int tid = threadIdx.x, lane = tid & 63, wave = tid >> 6;
    unsigned char* ws = P.ws;
    if (vcu < NB) {
        const int b = vcu, h = wave;
        const float* FLG = (const float*)(ws + WS_FLG) + (size_t)b * SEQ * 8 + h; float* FL = (float*)(ws + WS_FL) + ((size_t)b * 8 + h) * SEQ;
        const float bf = P.b_forget[h];
        float loc = 0.f;
        for (int i = 0; i < 64; ++i) loc += log_sigmoid(FLG[(size_t)(64 * lane + i) * 8] + bf);
        float incl = loc;
#pragma unroll
        for (int o = 1; o < 64; o <<= 1) { const float t = __shfl_up(incl, o); if (lane >= o) incl += t; }
        float run = incl - loc;
        for (int i = 0; i < 64; ++i) { run += log_sigmoid(FLG[(size_t)(64 * lane + i) * 8] + bf); FL[64 * lane + i] = run * LOG2E; }
    }
    const int gw = vcu * NWAVES + wave, NGW = G * NWAVES;
    bf16* QQ = (bf16*)(ws + WS_QQ); bf16* KK = (bf16*)(ws + WS_KK); bf16* IQ = (bf16*)(ws + WS_IQ); bf16* IK = (bf16*)(ws + WS_IK);
    const float* IKRAW = (const float*)(ws + WS_IKRAW); float* IW = (float*)(ws + WS_IW);
    const float* COS = (const float*)(ws + WS_COS); const float* SIN = (const float*)(ws + WS_SIN);
    const float ikg = P.ikg[lane], ikb = P.ikb[lane];
    for (int m = gw; m < M; m += NGW) {
        const float c = COS[(size_t)m * 8 + (lane & 7)], s = SIN[(size_t)m * 8 + (lane & 7)];
#pragma unroll
        for (int k = 0; k < 3; ++k) {
            const int p = lane + 64 * k, th = p >> 3, j = p & 7, head = th & 7;
            bf16* ptr = (k == 0 ? QQ + (size_t)m * 1024 + 512 : k == 1 ? KK + (size_t)m * 1024 + 512 : IQ + (size_t)m * 512) + head * 64 + j;
            const float t1 = bf2f(ptr[0]), t2 = bf2f(ptr[8]);
            ptr[0] = (bf16)f2bf(t1 * c - t2 * s); ptr[8] = (bf16)f2bf(t2 * c + t1 * s);
        }
        const float v = IKRAW[(size_t)m * 64 + lane];
        const float mean = wave_sum(v) * (1.f / 64.f); const float xc = v - mean;
        const float var = wave_sum(xc * xc) * (1.f / 64.f);
        float y = xc * (1.0f / sqrtf(var + LN_EPS)) * ikg + ikb;
        const float other = __shfl_xor(y, 8);
        if (lane < 8) y = y * c - other * s; else if (lane < 16) y = y * c + other * s;
        IK[(size_t)m * 64 + lane] = (bf16)f2bf(y);
        if (lane < 8) IW[(size_t)m * 8 + lane] *= IDX_SCALE;
    }
}

constexpr int IX_HIST = 0, IX_IQS = 65536, IX_IQ_PITCH = 1040, IX_SELB = IX_IQS + 32 * IX_IQ_PITCH, IX_CB = IX_SELB + 16384, IX_CC = IX_CB + 16384, IX_INFO = IX_CC + 8192;
constexpr int IX_WQ = IX_INFO + 512;
static_assert(IX_WQ + 1024 <= MISC_OFF, "indexer LDS map");
__device__ __forceinline__ unsigned ordered_key(float f) { const unsigned u = __builtin_bit_cast(unsigned, f); return u ^ ((u >> 31) ? 0xFFFFFFFFu : 0x80000000u); }
__device__ __forceinline__ void find_bucket(const LAS unsigned* hrow, int need, int lane, int& bin_out, int& above_out) {
    unsigned w[8];
#pragma unroll
    for (int j = 0; j < 8; ++j) w[j] = hrow[8 * lane + j];
    int tot = 0;
#pragma unroll
    for (int j = 0; j < 8; ++j) tot += (int)(w[j] & 0xFFFFu) + (int)(w[j] >> 16);
    int incl = tot;
#pragma unroll
    for (int o = 1; o < 64; o <<= 1) { const int t = __shfl_down(incl, o); if (lane + o < 64) incl += t; }
    const int S = incl - tot;
    int bin = -1, above = 0;
    if (S < need && S + tot >= need) {
        int acc = S; bool done = false;
#pragma unroll
        for (int i = 15; i >= 0; --i) { const int cnt = (i & 1) ? (int)(w[i >> 1] >> 16) : (int)(w[i >> 1] & 0xFFFFu);
            if (!done) { if (acc + cnt >= need) { bin = 16 * lane + i; above = acc; done = true; } else acc += cnt; } }
    }
    const unsigned long long bal = __ballot(bin >= 0);
    const int src = bal ? (int)__builtin_ctzll(bal) : 0;
    bin_out = __shfl(bin, src); above_out = __shfl(above, src);
}
__device__ __forceinline__ void p3_indexer(const Prm& P, LAS unsigned char* lds, int vcu, int G) {
    const int tid = threadIdx.x, lane = tid & 63, wave = tid >> 6, r32 = lane & 31, hi = lane >> 5;
    unsigned char* ws = P.ws;
    const bf16* IQ = (const bf16*)(ws + WS_IQ); const bf16* IK = (const bf16*)(ws + WS_IK); const float* IW = (const float*)(ws + WS_IW);
    unsigned* MASK = (unsigned*)(ws + WS_MASK);
    LAS unsigned* hist = (LAS unsigned*)(lds + IX_HIST);
    LAS unsigned long long* selb = (LAS unsigned long long*)(lds + IX_SELB);
    LAS unsigned long long* cb = (LAS unsigned long long*)(lds + IX_CB);
    LAS int* cc = (LAS int*)(lds + IX_CC);
    LAS int* info = (LAS int*)(lds + IX_INFO);
    const int NUN = NB * 64 * 2;
    for (int u0 = vcu; u0 < NUN; u0 += G) {
        const int u = NUN - 1 - u0;
        const int b = u & 15, rem = u >> 4, c = rem >> 1, half = rem & 1;
        const int m0 = b * SEQ + 64 * c + 32 * half;
        if (c < 4) {
            for (int i = tid; i < 32 * 2 * (c + 1); i += NTHR) { const int q = i / (2 * (c + 1)), w = i % (2 * (c + 1)); MASK[(size_t)(m0 + q) * 128 + w] = 0xFFFFFFFFu; }
            continue;
        }
        __syncthreads();
        for (int k = 0; k < 4; ++k) { const int id = tid + NTHR * k, row = id >> 6, ch = id & 63;
            *(LAS u32x4*)(lds + IX_IQS + row * IX_IQ_PITCH + ch * 16) = *(const u32x4*)(IQ + (size_t)(m0 + row) * 512 + ch * 8); }
        if (tid < 256) ((LAS float*)(lds + IX_WQ))[tid] = IW[(size_t)m0 * 8 + tid];
        for (int pass = 0; pass < 3; ++pass) {
            if (pass < 2) for (int i = tid; i < 32 * 512; i += NTHR) hist[i] = 0u;
            __syncthreads();
            int b1 = 0, t20 = 0;
            if (pass >= 1) b1 = info[r32];
            if (pass == 2) t20 = info[64 + r32];
            for (int t = wave; t <= c; t += NWAVES) {
                bf16x8 kf[4][2];
                const bf16* kp = IK + (size_t)(b * SEQ + 64 * t + r32) * 64 + 8 * hi;
#pragma unroll
                for (int d0 = 0; d0 < 4; ++d0) { kf[d0][0] = *(const bf16x8*)(kp + 16 * d0); kf[d0][1] = *(const bf16x8*)(kp + 32 * 64 + 16 * d0); }
                f32x16 sc0 = f32x16{}, sc1 = f32x16{};
#pragma unroll 1
                for (int h = 0; h < 8; ++h) {
                    const float wqh = ((const LAS float*)(lds + IX_WQ))[r32 * 8 + h];
                    f32x16 x0 = f32x16{}, x1 = f32x16{};
#pragma unroll
                    for (int d0 = 0; d0 < 4; ++d0) {
                        const bf16x8 qf = *(const LAS bf16x8*)(lds + IX_IQS + r32 * IX_IQ_PITCH + h * 128 + d0 * 32 + hi * 16);
                        x0 = __builtin_amdgcn_mfma_f32_32x32x16_bf16(kf[d0][0], qf, x0, 0, 0, 0);
                        x1 = __builtin_amdgcn_mfma_f32_32x32x16_bf16(kf[d0][1], qf, x1, 0, 0, 0);
                    }
#pragma unroll
                    for (int r = 0; r < 16; ++r) { sc0[r] += wqh * fmaxf(x0[r], 0.f); sc1[r] += wqh * fmaxf(x1[r], 0.f); }
                }
                unsigned sw0 = 0u, sw1 = 0u, cw0 = 0u, cw1 = 0u;
#pragma unroll
                for (int r = 0; r < 16; ++r) {
#pragma unroll
                    for (int hh = 0; hh < 2; ++hh) {
                        const int kin = crow(r, hi) + 32 * hh, kidx = 64 * t + kin;
                        const unsigned comp = (ordered_key(hh ? sc1[r] : sc0[r]) & 0xFFFFF000u) | (unsigned)(4095 - kidx);
                        if (pass == 0) { const unsigned bin = comp >> 22; atomicAdd((unsigned*)&hist[r32 * 512 + (bin >> 1)], 1u << (16 * (bin & 1))); }
                        else if (pass == 1) { if ((int)(comp >> 22) == b1) { const unsigned bin = (comp >> 12) & 1023u; atomicAdd((unsigned*)&hist[r32 * 512 + (bin >> 1)], 1u << (16 * (bin & 1))); } }
                        else { const int pf = (int)(comp >> 12); const unsigned s = pf > t20 ? 1u : 0u, cnd = pf == t20 ? 1u : 0u;
                            if (hh) { sw1 |= s << crow(r, hi); cw1 |= cnd << crow(r, hi); } else { sw0 |= s << crow(r, hi); cw0 |= cnd << crow(r, hi); } }
                    }
                }
                if (pass == 2) {
                    sw0 |= __shfl_xor(sw0, 32); sw1 |= __shfl_xor(sw1, 32); cw0 |= __shfl_xor(cw0, 32); cw1 |= __shfl_xor(cw1, 32);
                    if (hi == 0) { selb[r32 * 64 + t] = ((unsigned long long)sw1 << 32) | sw0; cb[r32 * 64 + t] = ((unsigned long long)cw1 << 32) | cw0;
                        cc[r32 * 64 + t] = __popc(cw0) + __popc(cw1); }
                }
            }
            __syncthreads();
            if (pass < 2) {
                for (int k = 0; k < 4; ++k) { const int row = wave * 4 + k;
                    const int need = pass == 0 ? TOPK : info[32 + row];
                    int bin, above; find_bucket(hist + row * 512, need, lane, bin, above);
                    if (lane == 0) { if (pass == 0) { info[row] = bin; info[32 + row] = need - above; } else { info[64 + row] = (info[row] << 10) | bin; info[96 + row] = need - above; } }
                }
                __syncthreads();
            }
        }
        if (tid < 32) { int run = info[96 + tid];
            for (int t = 0; t <= c; ++t) { const int n = cc[tid * 64 + t]; const int take = run < n ? run : n; cc[tid * 64 + t] = take; run -= take; } }
        __syncthreads();
        for (int k = 0; k < 4; ++k) { const int id = tid + NTHR * k, q = id >> 6, t = id & 63;
            if (t <= c) { int take = cc[q * 64 + t]; unsigned long long cbw = cb[q * 64 + t], outw = selb[q * 64 + t];
                while (take > 0) { const unsigned long long low = cbw & (0ull - cbw); outw |= low; cbw ^= low; --take; }
                *(u32x2*)(MASK + (size_t)(m0 + q) * 128 + 2 * t) = (u32x2){(unsigned)outw, (unsigned)(outw >> 32)}; } }
    }
}

constexpr int AT_KS = 0, AT_VT = 9216, AT_FL = 18432, AT_REL = 18432 + 256;
template <int MODE>
__device__ __forceinline__ void attn_simple(const Prm& P, LAS unsigned char* lds, int b, int h, int qb) {
    const int tid = threadIdx.x, lane = tid & 63, wid = tid >> 6, r32 = lane & 31, hi = lane >> 5;
    unsigned char* ws = P.ws;
    bf16* QQ = (bf16*)(ws + WS_QQ); const bf16* KK = (const bf16*)(ws + WS_KK); const bf16* VV = (const bf16*)(ws + WS_VV); const bf16* GG = (const bf16*)(ws + WS_GG);
    const int hc = MODE == 1 ? 8 + h : h;
    const int qpos = 256 * qb + 32 * wid + r32; const size_t qrow = (size_t)b * SEQ + qpos;
    const int cw = 4 * qb + (wid >> 1);
    const int t_lo = MODE == 2 ? (4 * qb - 8 > 0 ? 4 * qb - 8 : 0) : 0, t_hi = 4 * qb + 3;
    LAS bf16* Ks = (LAS bf16*)(lds + AT_KS); LAS bf16* Vt = (LAS bf16*)(lds + AT_VT); LAS float* FLs = (LAS float*)(lds + AT_FL); LAS float* REL = (LAS float*)(lds + AT_REL);
    bf16x8 qr[4];
#pragma unroll
    for (int d0 = 0; d0 < 4; ++d0) qr[d0] = *(const bf16x8*)(QQ + qrow * 1024 + hc * 64 + 16 * d0 + 8 * hi);
    const float* FL = (const float*)(ws + WS_FL) + ((size_t)b * 8 + h) * SEQ;
    float flq = 0.f; if (MODE == 0) flq = FL[qpos];
    const unsigned* mrow = (const unsigned*)(ws + WS_MASK) + qrow * 128;
    __syncthreads();
    if (MODE == 2) { if (tid < 257) REL[tid] = P.rel[h * 257 + tid] * LOG2E; }
    float m_run = -INFINITY, l_run = 0.f; f32x16 o[2]; o[0] = f32x16{}; o[1] = f32x16{};
    for (int t = t_lo; t <= t_hi; ++t) {
        __syncthreads();
        { const int key = tid >> 3, ch = tid & 7; const size_t src = ((size_t)b * SEQ + 64 * t + key) * 1024 + hc * 64 + ch * 8;
          *(LAS u32x4*)(Ks + key * 72 + ch * 8) = *(const u32x4*)(KK + src);
          const bf16x8 vv = *(const bf16x8*)(VV + src);
#pragma unroll
          for (int i = 0; i < 8; ++i) Vt[(ch * 8 + i) * 72 + key] = (bf16)vv[i];
          if (MODE == 0) { if (tid < 64) FLs[tid] = FL[64 * t + tid]; } }
        __syncthreads();
        const bool active = MODE == 2 ? (t >= cw - 8 && t <= cw) : (t <= cw);
        if (active) {
            f32x16 p0 = f32x16{}, p1 = f32x16{};
#pragma unroll
            for (int d0 = 0; d0 < 4; ++d0) {
                const bf16x8 a0 = *(const LAS bf16x8*)(Ks + r32 * 72 + 16 * d0 + 8 * hi), a1 = *(const LAS bf16x8*)(Ks + (32 + r32) * 72 + 16 * d0 + 8 * hi);
                p0 = __builtin_amdgcn_mfma_f32_32x32x16_bf16(a0, qr[d0], p0, 0, 0, 0);
                p1 = __builtin_amdgcn_mfma_f32_32x32x16_bf16(a1, qr[d0], p1, 0, 0, 0);
            }
            unsigned w0 = 0u, w1 = 0u; if (MODE == 1) { w0 = mrow[2 * t]; w1 = mrow[2 * t + 1]; }
#pragma unroll
            for (int r = 0; r < 16; ++r) {
                const int k0 = crow(r, hi), key0 = 64 * t + k0, key1 = key0 + 32;
                if (MODE == 0) { p0[r] += flq - FLs[k0]; p1[r] += flq - FLs[k0 + 32]; if (key0 > qpos) p0[r] = -INFINITY; if (key1 > qpos) p1[r] = -INFINITY; }
                if (MODE == 1) { if (!((w0 >> k0) & 1u)) p0[r] = -INFINITY; if (!((w1 >> k0) & 1u)) p1[r] = -INFINITY; }
                if (MODE == 2) { int d0i = qpos - key0, d1i = qpos - key1; d0i = d0i < -128 ? -128 : d0i > 128 ? 128 : d0i; d1i = d1i < -128 ? -128 : d1i > 128 ? 128 : d1i;
                    p0[r] += REL[d0i + 128]; p1[r] += REL[d1i + 128]; }
            }
            float rm = -INFINITY;
#pragma unroll
            for (int r = 0; r < 16; ++r) rm = fmaxf(rm, fmaxf(p0[r], p1[r]));
            rm = fmaxf(rm, __shfl_xor(rm, 32));
            const float m_new = fmaxf(m_run, rm);
            const float mref = m_new == -INFINITY ? 0.f : m_new;
            const float alpha = exp2f(m_run - mref);
            float ls = 0.f;
#pragma unroll
            for (int r = 0; r < 16; ++r) { p0[r] = exp2f(p0[r] - mref); p1[r] = exp2f(p1[r] - mref); ls += p0[r] + p1[r]; }
            l_run = l_run * alpha + ls; m_run = m_new;
#pragma unroll
            for (int r = 0; r < 16; ++r) { o[0][r] *= alpha; o[1][r] *= alpha; }
            u32x4 pw[4];
#pragma unroll
            for (int i = 0; i < 4; ++i) { pw[0][i] = pk2(p0[2 * i], p0[2 * i + 1]); pw[1][i] = pk2(p0[8 + 2 * i], p0[8 + 2 * i + 1]); pw[2][i] = pk2(p1[2 * i], p1[2 * i + 1]); pw[3][i] = pk2(p1[8 + 2 * i], p1[8 + 2 * i + 1]); }
#pragma unroll
            for (int d0 = 0; d0 < 2; ++d0)
#pragma unroll
                for (int j = 0; j < 4; ++j) {
                    const LAS bf16* vp = Vt + (r32 + 32 * d0) * 72 + 16 * j + 4 * hi;
                    const s16x4 lo = *(const LAS s16x4*)vp, hh = *(const LAS s16x4*)(vp + 8);
                    const bf16x8 a = (bf16x8){lo[0], lo[1], lo[2], lo[3], hh[0], hh[1], hh[2], hh[3]};
                    o[d0] = __builtin_amdgcn_mfma_f32_32x32x16_bf16(a, __builtin_bit_cast(bf16x8, pw[j]), o[d0], 0, 0, 0);
                }
        }
    }
    const float l_tot = l_run + __shfl_xor(l_run, 32);
    const float inv = 1.0f / l_tot;
    const bf16* gp = GG + qrow * 1024 + hc * 64; bf16* op = QQ + qrow * 1024 + hc * 64;
#pragma unroll
    for (int d0 = 0; d0 < 2; ++d0)
#pragma unroll
        for (int g = 0; g < 4; ++g) {
            const int d = 32 * d0 + 8 * g + 4 * hi;
            const u32x2 gv = *(const u32x2*)(gp + d);
            const float g0 = bf2f(gv.x & 0xFFFFu), g1 = bf2f(gv.x >> 16), g2 = bf2f(gv.y & 0xFFFFu), g3 = bf2f(gv.y >> 16);
            u32x2 ov; ov.x = pk2(o[d0][4 * g] * inv * silu(g0), o[d0][4 * g + 1] * inv * silu(g1)); ov.y = pk2(o[d0][4 * g + 2] * inv * silu(g2), o[d0][4 * g + 3] * inv * silu(g3));
            *(u32x2*)(op + d) = ov;
        }
}

__device__ __forceinline__ void p6_norm(const Prm& P, int vcu, int G) {
    const int lane = threadIdx.x & 63, wave = threadIdx.x >> 6, gw = vcu * NWAVES + wave, NGW = G * NWAVES;
    const bf16* Y = (const bf16*)(P.ws + WS_Y); bf16* H = (bf16*)(P.ws + WS_H);
    for (int m = gw; m < M; m += NGW) {
        const unsigned long long* yr = (const unsigned long long*)(Y + (size_t)m * DM) + lane;
        const f32x4* xr = (const f32x4*)(P.x + (size_t)m * DM) + lane; const f32x4* pg = (const f32x4*)P.post_g + lane; const f32x4* g1 = (const f32x4*)(P.pre_g + DM) + lane;
        f32x4 y[4]; float s = 0.f;
#pragma unroll
        for (int j = 0; j < 4; ++j) { const unsigned long long w = yr[64 * j]; y[j] = (f32x4){bf2f((unsigned)w & 0xFFFFu), bf2f(((unsigned)w) >> 16), bf2f((unsigned)(w >> 32) & 0xFFFFu), bf2f((unsigned)(w >> 48))};
            s += (y[j].x * y[j].x + y[j].y * y[j].y) + (y[j].z * y[j].z + y[j].w * y[j].w); }
        const float rs = 1.0f / sqrtf(wave_sum(s) * (1.f / DM) + RMS_EPS);
        float s2 = 0.f;
#pragma unroll
        for (int j = 0; j < 4; ++j) { y[j] = xr[64 * j] + y[j] * rs * pg[64 * j]; s2 += (y[j].x * y[j].x + y[j].y * y[j].y) + (y[j].z * y[j].z + y[j].w * y[j].w); }
        const float rs2 = 1.0f / sqrtf(wave_sum(s2) * (1.f / DM) + RMS_EPS);
        f32x4* orow = (f32x4*)(P.out + (size_t)m * DM) + lane; unsigned long long* hr = (unsigned long long*)(H + (size_t)m * DM) + lane;
#pragma unroll
        for (int j = 0; j < 4; ++j) { orow[64 * j] = y[j]; const f32x4 gg = g1[64 * j];
            hr[64 * j] = (unsigned long long)pk2(y[j].x * rs2 * gg.x, y[j].y * rs2 * gg.y) | ((unsigned long long)pk2(y[j].z * rs2 * gg.z, y[j].w * rs2 * gg.w) << 32); }
    }
}
__device__ __forceinline__ void p10_final(const Prm& P, int vcu, int G) {
    const int lane = threadIdx.x & 63, wave = threadIdx.x >> 6, gw = vcu * NWAVES + wave, NGW = G * NWAVES;
    const bf16* Y = (const bf16*)(P.ws + WS_Y);
    for (int m = gw; m < M; m += NGW) {
        const unsigned long long* yr = (const unsigned long long*)(Y + (size_t)m * DM) + lane;
        f32x4* orow = (f32x4*)(P.out + (size_t)m * DM) + lane; const f32x4* pg = (const f32x4*)(P.post_g + DM) + lane;
        f32x4 y[4]; float s = 0.f;
#pragma unroll
        for (int j = 0; j < 4; ++j) { const unsigned long long w = yr[64 * j]; y[j] = (f32x4){bf2f((unsigned)w & 0xFFFFu), bf2f(((unsigned)w) >> 16), bf2f((unsigned)(w >> 32) & 0xFFFFu), bf2f((unsigned)(w >> 48))};
            s += (y[j].x * y[j].x + y[j].y * y[j].y) + (y[j].z * y[j].z + y[j].w * y[j].w); }
        const float rs = 1.0f / sqrtf(wave_sum(s) * (1.f / DM) + RMS_EPS);
#pragma unroll
        for (int j = 0; j < 4; ++j) orow[64 * j] = orow[64 * j] + y[j] * rs * pg[64 * j];
    }
}

constexpr int NPHASE = 11;
__global__ void __launch_bounds__(NTHR, 2) fwd(Prm P) {
    extern __shared__ __attribute__((aligned(16))) unsigned char lds_raw[];
    LAS unsigned char* lds = (LAS unsigned char*)lds_raw;
    const int G = gridDim.x, bx = blockIdx.x;
    const int vcu = (G % 8 == 0) ? (bx % 8) * (G / 8) + bx / 8 : bx;
    const int lo = P.ph_lo, hi = P.ph_hi;
    unsigned char* ws = P.ws;
#define IN(k) (lo <= (k) && (k) < hi)
    if (IN(0)) p0_prologue(P, lds, vcu, G);
    if (IN(1)) { EpiProj0 E{ws}; gemm_simple(((const bf16*)(ws + WS_H)), (const bf16*)(ws + WS_W0T), N0, E, vcu, G); }
    if (IN(2)) p2_post(P, vcu, G);
    if (IN(3)) p3_indexer(P, lds, vcu, G);
    if (IN(4)) {
        const int NUN = 2 * NB * 8 * 16;
        for (int u0 = vcu; u0 < NUN; u0 += G) { const int qb = 15 - (u0 >> 8), rem = u0 & 255, mode = rem & 1, bh = rem >> 1, b = bh >> 3, h = bh & 7;
            if (mode == 0) attn_simple<0>(P, lds, b, h, qb); else attn_simple<1>(P, lds, b, h, qb); }
    }
    if (IN(5)) { EpiY E{(bf16*)(ws + WS_Y)}; gemm_simple((const bf16*)(ws + WS_QQ), (const bf16*)(ws + WS_WO0T), 1024, E, vcu, G); }
    if (IN(6)) p6_norm(P, vcu, G);
    if (IN(7)) { EpiProj1 E{ws}; gemm_simple((const bf16*)(ws + WS_H), (const bf16*)(ws + WS_W1T), N1, E, vcu, G); }
    if (IN(8)) {
        const int NUN = NB * 16 * 16;
        for (int u0 = vcu; u0 < NUN; u0 += G) { const int qb = u0 >> 8, bh = u0 & 255, b = bh >> 4, h = bh & 15; attn_simple<2>(P, lds, b, h, qb); }
    }
    if (IN(9)) { EpiY E{(bf16*)(ws + WS_Y)}; gemm_simple((const bf16*)(ws + WS_QQ), (const bf16*)(ws + WS_WO1T), 1024, E, vcu, G); }
    if (IN(10)) p10_final(P, vcu, G);
#undef IN
}

extern "C" void kernel_launch(void* const* d_in, const int* in_sizes, int n_in, void* d_out, int out_size, void* d_ws, size_t ws_size, hipStream_t stream) {
    static int grid = 0;
    if (grid == 0) {
        if (n_in != 12 || in_sizes[0] != M * DM || out_size != M * DM || ws_size < WS_END) { fprintf(stderr, "kernel_launch: unexpected shapes (n_in %d, ws %zu)\n", n_in, ws_size); grid = -1; return; }
        int dev = 0, cus = 0;
        if (hipGetDevice(&dev) != hipSuccess || hipDeviceGetAttribute(&cus, hipDeviceAttributeMultiprocessorCount, dev) != hipSuccess) { grid = -1; return; }
        if (hipFuncSetAttribute((const void*)fwd, hipFuncAttributeMaxDynamicSharedMemorySize, LDS_BYTES) != hipSuccess) { grid = -1; return; }
        grid = cus;
    }
    if (grid < 0) return;
    Prm p{};
    p.x = (const float*)d_in[0]; p.pos = (const int*)d_in[1]; p.pre_g = (const float*)d_in[2]; p.post_g = (const float*)d_in[3]; p.w_in0 = (const float*)d_in[4];
    p.b_forget = (const float*)d_in[5]; p.ikg = (const float*)d_in[6]; p.ikb = (const float*)d_in[7]; p.w_out0 = (const float*)d_in[8]; p.w_in1 = (const float*)d_in[9];
    p.rel = (const float*)d_in[10]; p.w_out1 = (const float*)d_in[11];
    p.out = (float*)d_out; p.ws = (unsigned char*)d_ws;
    for (int ph = 0; ph < NPHASE; ++ph) {
        p.ph_lo = ph; p.ph_hi = ph + 1;
        hipLaunchKernelGGL(fwd, dim3(grid), dim3(NTHR), LDS_BYTES, stream, p);
    }
}
```

```cpp
#include <hip/hip_runtime.h>
#include <cstdio>
#include <cstdint>
#include <cmath>

#define GAS __attribute__((address_space(1)))
#define LAS __attribute__((address_space(3)))
typedef unsigned short bf16;
typedef short bf16x8 __attribute__((ext_vector_type(8)));
typedef short s16x4 __attribute__((ext_vector_type(4)));
typedef float f32x4 __attribute__((ext_vector_type(4)));
typedef float f32x16 __attribute__((ext_vector_type(16)));
typedef unsigned u32x4 __attribute__((ext_vector_type(4)));
typedef unsigned u32x2 __attribute__((ext_vector_type(2)));

constexpr int NB = 16, SEQ = 4096, DM = 1024, M = NB * SEQ;
constexpr int N0 = 4864;
constexpr int N1 = 4096;
constexpr float LOG2E = 1.4426950408889634f;
constexpr float C2 = 0.125f * LOG2E;
constexpr float RMS_EPS = 1e-6f, LN_EPS = 1e-6f;
constexpr float IDX_SCALE = 0.04419417382415922f;
constexpr int TOPK = 256;
constexpr int NWAVES = 8, NTHR = 512;

constexpr size_t MiB = 1u << 20;
constexpr size_t WS_CTL = 0, CTL_ZERO_BYTES = 64 * 1024;
constexpr size_t WS_W0T = 1 * MiB;
constexpr size_t WS_WO0T = 11 * MiB;
constexpr size_t WS_W1T = 13 * MiB;
constexpr size_t WS_WO1T = 21 * MiB;
constexpr size_t WS_FLG = 23 * MiB;
constexpr size_t WS_IW = 25 * MiB;
constexpr size_t WS_IKRAW = 27 * MiB;
constexpr size_t WS_IK = 43 * MiB;
constexpr size_t WS_FL = 51 * MiB;
constexpr size_t WS_COS = 53 * MiB;
constexpr size_t WS_SIN = 55 * MiB;
constexpr size_t WS_MASK = 57 * MiB;
constexpr size_t WS_H = 96 * MiB;
constexpr size_t WS_QQ = 224 * MiB;
constexpr size_t WS_KK = 352 * MiB;
constexpr size_t WS_VV = 480 * MiB;
constexpr size_t WS_GG = 608 * MiB;
constexpr size_t WS_IQ = 736 * MiB;
constexpr size_t WS_Y = 800 * MiB;
constexpr size_t WS_END = 928 * MiB;
static_assert(WS_MASK + (size_t)M * 512 <= WS_H && WS_IQ + (size_t)M * 1024 <= WS_Y, "ws map");

constexpr int CW_QUEUE = 2048;
constexpr int CW_KMAX = 1024;
constexpr int LDS_BYTES = 163840;
constexpr int MISC_OFF = LDS_BYTES - 256;

struct Prm {
    const float* x; const int* pos; const float* pre_g; const float* post_g; const float* w_in0; const float* b_forget; const float* ikg; const float* ikb;
    const float* w_out0; const float* w_in1; const float* rel; const float* w_out1;
    float* out; unsigned char* ws;
    int ph_lo, ph_hi, li, o_alt;
};

__device__ __forceinline__ int crow(int r, int hi) { return (r & 3) + 8 * (r >> 2) + 4 * hi; }
__device__ __forceinline__ unsigned f2bf(float f) { unsigned u = __builtin_bit_cast(unsigned, f); return (u + 0x7fffu + ((u >> 16) & 1u)) >> 16; }
__device__ __forceinline__ float bf2f(unsigned h) { return __builtin_bit_cast(float, h << 16); }
__device__ __forceinline__ unsigned pk2(float lo, float hi) { return f2bf(lo) | (f2bf(hi) << 16); }
__device__ __forceinline__ float wave_sum(float v) {
#pragma unroll
    for (int o = 1; o < 64; o <<= 1) v += __shfl_xor(v, o);
    return v;
}
__device__ __forceinline__ float silu(float g) { return g / (1.f + __expf(-g)); }
__device__ __forceinline__ float log_sigmoid(float v) { return fminf(v, 0.f) - log1pf(expf(-fabsf(v))); }
__device__ __forceinline__ int opaque_tid() { int t = threadIdx.x; asm volatile("" : "+v"(t)); return t; }

#define DIAG_T0(P) do {} while (0)
#define DIAG_ACC(P, k) do {} while (0)
__device__ __forceinline__ int w0_src_col(int n) {
    if (n < 4096) { const int seg = n >> 9, off = n & 511;
        const int base = seg == 0 ? 0 : seg == 1 ? 2056 : seg == 2 ? 512 : seg == 3 ? 2568 : seg == 4 ? 1024 : seg == 5 ? 3080 : seg == 6 ? 1544 : 4176;
        return base + off; }
    if (n < 4608) return 3592 + (n - 4096);
    if (n < 4672) return 4104 + (n - 4608);
    if (n < 4680) return 1536 + (n - 4672);
    if (n < 4688) return 4168 + (n - 4680);
    return -1;
}
template <bool MAP0>
__device__ __forceinline__ void transpose_item(const float* W, int Nsrc, int Ndst, bf16* WT, LAS float* scr, int item, int lane, const float* kg = nullptr) {
    const int nblk = Ndst / 32, kb = item / nblk, nb = item % nblk, k0 = 64 * kb, n0 = 32 * nb;
    const int nd = n0 + (lane & 31); const int ns = MAP0 ? w0_src_col(nd) : nd;
#pragma unroll 8
    for (int i = 0; i < 32; ++i) { const int kk = 2 * i + (lane >> 5); scr[kk * 33 + (lane & 31)] = ns >= 0 ? W[(size_t)(k0 + kk) * Nsrc + ns] * (kg ? kg[k0 + kk] : 1.f) : 0.f; }
    asm volatile("s_waitcnt lgkmcnt(0)" ::: "memory");
    const int c = lane & 7;
#pragma unroll
    for (int j = 0; j < 4; ++j) { const int n = (lane >> 3) + 8 * j; const LAS float* s = scr + (8 * c) * 33 + n;
        u32x4 o; o.x = pk2(s[0 * 33], s[1 * 33]); o.y = pk2(s[2 * 33], s[3 * 33]); o.z = pk2(s[4 * 33], s[5 * 33]); o.w = pk2(s[6 * 33], s[7 * 33]);
        *(u32x4*)(WT + (size_t)(n0 + n) * 1024 + k0 + 8 * c) = o; }
    asm volatile("s_waitcnt lgkmcnt(0)" ::: "memory");
}
__device__ __forceinline__ void rms_rows_to_bf16(const float* srcA, const float* srcB, const float* g, bf16* dstA, bf16* dstB, int lane) {
    const f32x4* gr = (const f32x4*)g + lane;
    f32x4 v[2][4];
#pragma unroll
    for (int i = 0; i < 2; ++i) { const f32x4* xr = (const f32x4*)(i ? srcB : srcA) + lane;
#pragma unroll
        for (int j = 0; j < 4; ++j) v[i][j] = xr[64 * j]; }
    f32x4 gg[4];
#pragma unroll
    for (int j = 0; j < 4; ++j) gg[j] = gr[64 * j];
#pragma unroll
    for (int i = 0; i < 2; ++i) { float s = 0.f;
#pragma unroll
        for (int j = 0; j < 4; ++j) s += (v[i][j].x * v[i][j].x + v[i][j].y * v[i][j].y) + (v[i][j].z * v[i][j].z + v[i][j].w * v[i][j].w);
        const float rs = 1.0f / sqrtf(wave_sum(s) * (1.f / DM) + RMS_EPS);
        unsigned long long* o8 = (unsigned long long*)(i ? dstB : dstA) + lane;
#pragma unroll
        for (int j = 0; j < 4; ++j)
            o8[64 * j] = (unsigned long long)pk2(v[i][j].x * rs * gg[j].x, v[i][j].y * rs * gg[j].y) | ((unsigned long long)pk2(v[i][j].z * rs * gg[j].z, v[i][j].w * rs * gg[j].w) << 32); }
}
__device__ __forceinline__ void p0_prologue(const Prm& P, LAS unsigned char* lds, int vcu, int G) {
    const int tid = opaque_tid(), lane = tid & 63, wave = tid >> 6;
    LAS float* scr = (LAS float*)(lds + wave * 16384);
    const int gw = vcu * NWAVES + wave, NGW = G * NWAVES;
    unsigned char* ws = P.ws;
    constexpr int I0 = 16 * (N0 / 32), IO = 16 * 32, I1 = 16 * (N1 / 32);
    constexpr int NIT = I0 + IO + I1 + IO;
    for (int it = gw; it < NIT; it += NGW) {
        int r = it;
        if (r < I0) { transpose_item<true>(P.w_in0, 4688, N0, (bf16*)(ws + WS_W0T), scr, r, lane); continue; } r -= I0;
        if (r < IO) { transpose_item<false>(P.w_out0, 1024, 1024, (bf16*)(ws + WS_WO0T), scr, r, lane); continue; } r -= IO;
        if (r < I1) { transpose_item<false>(P.w_in1, N1, N1, (bf16*)(ws + WS_W1T), scr, r, lane, P.pre_g + DM); continue; } r -= I1;
        transpose_item<false>(P.w_out1, 1024, 1024, (bf16*)(ws + WS_WO1T), scr, r, lane);
    }
    bf16* H = (bf16*)(ws + WS_H);
    for (int m = gw; m < M; m += 2 * NGW) { const int m2 = m + NGW < M ? m + NGW : m; rms_rows_to_bf16(P.x + (size_t)m * DM, P.x + (size_t)m2 * DM, P.pre_g, H + (size_t)m * DM, H + (size_t)m2 * DM, lane); }
    float* COS = (float*)(ws + WS_COS); float* SIN = (float*)(ws + WS_SIN);
    for (int idx = vcu * NTHR + tid; idx < M * 8; idx += G * NTHR) {
        const int m = idx >> 3, j = idx & 7;
        const float inv_freq = powf(500000.0f, -(float)j * 0.125f);
        const float ang = (float)P.pos[m] * inv_freq;
        COS[idx] = cosf(ang); SIN[idx] = sinf(ang);
    }
}

namespace pg8 {
#define PG8_LAS __attribute__((address_space(3)))
typedef unsigned short bf16_t;
typedef short bf16x8 __attribute__((ext_vector_type(8)));
typedef float f32x4 __attribute__((ext_vector_type(4)));
typedef unsigned u32x4 __attribute__((ext_vector_type(4)));
constexpr int BM = 256, BK = 64, HALF = 128, HTB = HALF * BK * 2  , STAGE_BYTES = 8 * HTB, NXCD = 8, WGM = 8;

__host__ __device__ __forceinline__ int lds_byte(int r, int c) { const int st = (r >> 4) * 2 + (c >> 5), rr = r & 15, cc = c & 31, ob = rr * 64 + cc * 2; return st * 1024 + (ob ^ (((ob >> 9) & 1) << 5)); }
__host__ __device__ __forceinline__ void stage_rc(int b, int& R, int& C) { const int st = b / 1024, sb = b % 1024, swz = sb ^ (((sb >> 9) & 1) << 5); R = (st >> 1) * 16 + swz / 64; C = (st & 1) * 32 + (swz % 64) / 2; }
__host__ __device__ __forceinline__ int perm32(int rho) { const int n = rho >> 4, i = rho & 15; return 8 * (i >> 2) + 4 * n + (i & 3); }

struct Unit { int pm, pn; };
struct Gemm { const bf16_t* A; const bf16_t* Bt; int M, N, K; };

struct StaticOrder {
    int nM, nN, nwg, G, c;
    __host__ __device__ void init(int M, int N, int G_, int c_) { nM = M / BM; nN = N / BM; nwg = nM * nN; G = G_; c = c_; }
    __host__ __device__ bool next(int i, Unit& u) const {
        const long L = (long)i * G + c; if (L >= nwg) return false;
        int wgid = (int)L; { const int q = nwg / NXCD, r = nwg % NXCD, xcd = wgid % NXCD, off = wgid / NXCD; wgid = (xcd < r ? xcd * (q + 1) : r * (q + 1) + (xcd - r) * q) + off; }
        const int nig = WGM * nN, gid = wgid / nig, fm = gid * WGM, gsz = (nM - fm) < WGM ? (nM - fm) : WGM;
        u.pm = fm + ((wgid % nig) % gsz); u.pn = (wgid % nig) / gsz; return true;
    }
    __device__ __forceinline__ void a_ready(const Unit&) const {}
    __device__ __forceinline__ void done(const Unit&) const {}
};

__device__ __forceinline__ unsigned cvt_pk_bf16(float lo, float hi) { unsigned r; asm volatile("v_cvt_pk_bf16_f32 %0, %1, %2" : "=v"(r) : "v"(lo), "v"(hi)); return r; }

template <class Epi, class Sched, bool ALIGN_EPI = false, bool SP2 = false>
__device__ __forceinline__ void gemm_phase(PG8_LAS unsigned char* lds, const Gemm g, const Sched& S, const Epi& E) {
    const int tid = threadIdx.x, wid = __builtin_amdgcn_readfirstlane(tid >> 6), lane = tid & 63, wr = wid >> 2, wc = wid & 3, fr = lane & 15, fq = lane >> 4;
    const int K = g.K, nt = K / BK;
    unsigned voffA[2], voffB[2];
#pragma unroll
    for (int i = 0; i < 2; ++i) { int R, C; stage_rc(tid * 16 + i * 8192, R, C); const int Rb = Epi::PERM ? ((R & ~31) + perm32(R & 31)) : R;
        voffA[i] = (unsigned)(R * K + C) * 2u; voffB[i] = (unsigned)(Rb * K + C) * 2u; }
    const size_t kstep = (size_t)(BK * 2);
    const size_t hstep = (size_t)HALF * K * 2;
    const size_t tstep = 2 * hstep;
    const unsigned ldsw = (unsigned)wid * 1024u;
    const int aoff = lds_byte(wr * 64 + fr, fq * 8), boff = lds_byte(wc * 32 + fr, fq * 8);
#define PG8_SA(b, h) (((b) * 2 + (h)) * HTB)
#define PG8_SB(b, h) ((4 + (b) * 2 + (h)) * HTB)
#define PG8_STAGE(bufoff, gbase, voff) do { _Pragma("unroll") for (int _i = 0; _i < 2; ++_i) \
        __builtin_amdgcn_global_load_lds((const unsigned*)((const char*)(gbase) + (voff)[_i]), (PG8_LAS unsigned*)(lds + (bufoff) + ldsw + _i * 8192), 16, 0, 0); } while (0)
#define PG8_LDA(dst, b, h) do { _Pragma("unroll") for (int m = 0; m < 4; ++m) _Pragma("unroll") for (int k = 0; k < 2; ++k) dst[m][k] = *(const PG8_LAS bf16x8*)(lds + PG8_SA(b, h) + aoff + m * 2048 + k * 1024); } while (0)
#define PG8_LDB(dst, b, h) do { _Pragma("unroll") for (int n = 0; n < 2; ++n) _Pragma("unroll") for (int k = 0; k < 2; ++k) dst[n][k] = *(const PG8_LAS bf16x8*)(lds + PG8_SB(b, h) + boff + n * 2048 + k * 1024); } while (0)
#define PG8_MMA(ai, bj, At, Bt) do { __builtin_amdgcn_s_setprio(1); _Pragma("unroll") for (int m = 0; m < 4; ++m) _Pragma("unroll") for (int n = 0; n < 2; ++n) _Pragma("unroll") for (int k = 0; k < 2; ++k) \
        acc[ai][bj][m][n] = __builtin_amdgcn_mfma_f32_16x16x32_bf16(Bt[n][k], At[m][k], acc[ai][bj][m][n], 0, 0, 0); __builtin_amdgcn_s_setprio(0); } while (0)
#define PG8_WAIT_V(n) asm volatile("s_waitcnt vmcnt(" #n ")" ::: "memory")
#define PG8_WAIT_L(n) asm volatile("s_waitcnt lgkmcnt(" #n ")" ::: "memory")
#define PG8_BAR __builtin_amdgcn_s_barrier()
#define PG8_SCHED __builtin_amdgcn_sched_barrier(0)
    Unit cur, nxt; int ui = 0;
    if (!S.next(0, cur)) return;
    f32x4 acc[2][2][4][2];
#pragma unroll
    for (int a = 0; a < 2; ++a)
#pragma unroll
        for (int b = 0; b < 2; ++b)
#pragma unroll
            for (int m = 0; m < 4; ++m)
#pragma unroll
                for (int n = 0; n < 2; ++n) acc[a][b][m][n] = (f32x4){0.f, 0.f, 0.f, 0.f};
    bf16x8 At[4][2], B0[2][2], B1[2][2];
    const char* cA = (const char*)g.A + (size_t)cur.pm * tstep; const char* cB = (const char*)g.Bt + (size_t)cur.pn * tstep;
    S.a_ready(cur);
    if constexpr (SP2) {
        PG8_STAGE(PG8_SB(0, 0), cB, voffB); PG8_STAGE(PG8_SB(0, 1), cB + hstep, voffB); PG8_STAGE(PG8_SA(0, 0), cA, voffA); PG8_STAGE(PG8_SA(0, 1), cA + hstep, voffA);
        if (wr == 1) PG8_BAR;
        PG8_WAIT_V(2); PG8_BAR;
        PG8_STAGE(PG8_SB(1, 0), cB + kstep, voffB); PG8_STAGE(PG8_SA(1, 0), cA + kstep, voffA); PG8_STAGE(PG8_SB(1, 1), cB + hstep + kstep, voffB);
        PG8_WAIT_V(6); PG8_BAR;
    } else {
        PG8_STAGE(PG8_SB(0, 0), cB, voffB); PG8_STAGE(PG8_SA(0, 0), cA, voffA); PG8_STAGE(PG8_SB(0, 1), cB + hstep, voffB); PG8_STAGE(PG8_SA(0, 1), cA + hstep, voffA);
        if (wr == 1) PG8_BAR;
        PG8_WAIT_V(4); PG8_BAR;
        PG8_STAGE(PG8_SB(1, 0), cB + kstep, voffB); PG8_STAGE(PG8_SA(1, 0), cA + kstep, voffA); PG8_STAGE(PG8_SB(1, 1), cB + hstep + kstep, voffB);
        PG8_WAIT_V(6); PG8_BAR;
    }
    for (;;) {
        const bool has_next = S.next(ui + 1, nxt);
        const char* nA = has_next ? (const char*)g.A + (size_t)nxt.pm * tstep : cA; const char* nB = has_next ? (const char*)g.Bt + (size_t)nxt.pn * tstep : cB;
        for (int t = 0; t < nt; t += 2) {
            const bool last = (t == nt - 2);
            const char* a1 = cA + (size_t)(t + 1) * kstep;
            const char* a2 = last ? nA : cA + (size_t)(t + 2) * kstep; const char* b2 = last ? nB : cB + (size_t)(t + 2) * kstep;
            const char* a3 = a2 + kstep; const char* b3 = b2 + kstep;
            if (last && has_next) S.a_ready(nxt);
            if constexpr (SP2) {
            PG8_LDB(B0, 0, 0); PG8_LDB(B1, 0, 1); PG8_SCHED; PG8_LDA(At, 0, 0); PG8_STAGE(PG8_SA(1, 1), a1 + hstep, voffA);
            PG8_WAIT_V(8); PG8_WAIT_L(0); PG8_BAR; PG8_MMA(0, 0, At, B0); PG8_MMA(0, 1, At, B1); PG8_BAR; PG8_SCHED;
            PG8_LDA(At, 0, 1); PG8_STAGE(PG8_SB(0, 0), b2, voffB); PG8_STAGE(PG8_SB(0, 1), b2 + hstep, voffB); PG8_STAGE(PG8_SA(0, 0), a2, voffA);
            PG8_WAIT_V(8); PG8_WAIT_L(0); PG8_BAR; PG8_MMA(1, 0, At, B0); PG8_MMA(1, 1, At, B1); PG8_BAR; PG8_SCHED;
            PG8_LDB(B0, 1, 0); PG8_LDB(B1, 1, 1); PG8_SCHED; PG8_LDA(At, 1, 0); PG8_STAGE(PG8_SA(0, 1), a2 + hstep, voffA);
            PG8_WAIT_V(8); PG8_WAIT_L(0); PG8_BAR; PG8_MMA(0, 0, At, B0); PG8_MMA(0, 1, At, B1); PG8_BAR; PG8_SCHED;
            PG8_LDA(At, 1, 1); PG8_STAGE(PG8_SB(1, 0), b3, voffB); PG8_STAGE(PG8_SB(1, 1), b3 + hstep, voffB); PG8_STAGE(PG8_SA(1, 0), a3, voffA);
            PG8_WAIT_V(8); PG8_WAIT_L(0); PG8_BAR; PG8_MMA(1, 0, At, B0); PG8_MMA(1, 1, At, B1); PG8_BAR; PG8_SCHED;
            } else {
            PG8_LDB(B0, 0, 0); PG8_SCHED; PG8_LDA(At, 0, 0); PG8_STAGE(PG8_SA(1, 1), a1 + hstep, voffA);
            PG8_WAIT_L(8); PG8_BAR; PG8_WAIT_L(0); PG8_MMA(0, 0, At, B0); PG8_BAR; PG8_SCHED;
            PG8_LDB(B1, 0, 1); PG8_STAGE(PG8_SB(0, 0), b2, voffB);
            PG8_BAR; PG8_WAIT_L(0); PG8_MMA(0, 1, At, B1); PG8_BAR;
            PG8_LDA(At, 0, 1); PG8_STAGE(PG8_SA(0, 0), a2, voffA);
            PG8_BAR; PG8_WAIT_L(0); PG8_MMA(1, 0, At, B0); PG8_BAR; PG8_SCHED;
            PG8_STAGE(PG8_SB(0, 1), b2 + hstep, voffB);
            PG8_WAIT_V(6); PG8_BAR; PG8_MMA(1, 1, At, B1); PG8_BAR;
            PG8_LDB(B0, 1, 0); PG8_SCHED; PG8_LDA(At, 1, 0); PG8_STAGE(PG8_SA(0, 1), a2 + hstep, voffA);
            PG8_WAIT_L(8); PG8_BAR; PG8_WAIT_L(0); PG8_MMA(0, 0, At, B0); PG8_BAR; PG8_SCHED;
            PG8_LDB(B1, 1, 1); PG8_STAGE(PG8_SB(1, 0), b3, voffB);
            PG8_BAR; PG8_WAIT_L(0); PG8_MMA(0, 1, At, B1); PG8_BAR;
            PG8_LDA(At, 1, 1); PG8_STAGE(PG8_SA(1, 0), a3, voffA);
            PG8_BAR; PG8_WAIT_L(0); PG8_MMA(1, 0, At, B0); PG8_BAR; PG8_SCHED;
            PG8_STAGE(PG8_SB(1, 1), b3 + hstep, voffB);
            PG8_WAIT_V(6); PG8_BAR; PG8_MMA(1, 1, At, B1); PG8_BAR;
            }
        }
        if constexpr (ALIGN_EPI) { if (wr == 0) PG8_BAR; }
        if constexpr (!Epi::AFTER_DRAIN) { E(acc, cur, wr, wc, fr, fq); S.done(cur); }
        if (!has_next) break;
#pragma unroll
        for (int a = 0; a < 2; ++a)
#pragma unroll
            for (int b = 0; b < 2; ++b)
#pragma unroll
                for (int m = 0; m < 4; ++m)
#pragma unroll
                    for (int n = 0; n < 2; ++n) acc[a][b][m][n] = (f32x4){0.f, 0.f, 0.f, 0.f};
        cur = nxt; cA = nA; cB = nB; ++ui;
        if constexpr (ALIGN_EPI) { if (wr == 1) PG8_BAR; }
    }
    PG8_WAIT_V(0);
    if constexpr (!ALIGN_EPI) { if (wr == 0) PG8_BAR; }
    PG8_BAR;
    if constexpr (Epi::AFTER_DRAIN) { E.fused(acc, cur, wr, wc, fr, fq, lds, wid, lane); S.done(cur); }
#undef PG8_SA
#undef PG8_SB
#undef PG8_STAGE
#undef PG8_LDA
#undef PG8_LDB
#undef PG8_MMA
#undef PG8_WAIT_V
#undef PG8_WAIT_L
#undef PG8_BAR
#undef PG8_SCHED
}


template <bool ROPE>
struct EpiProj {
    static constexpr bool PERM = true, AFTER_DRAIN = false;
    unsigned char* ws; const float* b_forget; int col_off; int rope_on; const float* rowscale;
    __device__ __forceinline__ void operator()(const f32x4 (&acc)[2][2][4][2], const Unit& u, int wr, int wc, int fr, int fq) const {
        const int row0 = u.pm * BM + wr * 64 + fr, colt = col_off + u.pn * BM, lc0 = wc * 32 + 8 * fq;
        if (colt < 4608) {
            bf16_t* base; int pitch; float sc = 1.f;
            if (colt < 4096) { const int t = colt >> 10; base = (bf16_t*)(ws + WS_QQ + (size_t)t * (WS_KK - WS_QQ)) + (colt & 1023) + lc0; pitch = 1024; if (t == 0) sc = C2; }
            else { base = (bf16_t*)(ws + WS_IQ) + (colt - 4096) + lc0; pitch = 512; }
            const bool rope = ROPE && rope_on && !(wc & 1) && ((colt >= 512 && colt < 1024) || (colt >= 1536 && colt < 2048) || colt >= 4096);
            float rsc[2][4];
#pragma unroll
            for (int ai = 0; ai < 2; ++ai)
#pragma unroll
                for (int m = 0; m < 4; ++m) rsc[ai][m] = rowscale ? rowscale[(size_t)(row0 + ai * HALF + m * 16) * 8] * sc : sc;
#pragma unroll
            for (int ai = 0; ai < 2; ++ai) {
                f32x4 cs[4][4];
                if (rope) {
#pragma unroll
                    for (int m = 0; m < 4; ++m) { const size_t row = (size_t)(row0 + ai * HALF + m * 16); const float* cp = (const float*)(ws + WS_COS) + row * 8; const float* sp = (const float*)(ws + WS_SIN) + row * 8;
                        cs[m][0] = *(const f32x4*)cp; cs[m][1] = *(const f32x4*)(cp + 4); cs[m][2] = *(const f32x4*)sp; cs[m][3] = *(const f32x4*)(sp + 4);
                        if (fq == 0) { cs[m][2] = -cs[m][2]; cs[m][3] = -cs[m][3]; } }
                }
#pragma unroll
                for (int m = 0; m < 4; ++m) { const size_t row = (size_t)(row0 + ai * HALF + m * 16); bf16_t* rowp = base + row * pitch;
#pragma unroll
                    for (int bj = 0; bj < 2; ++bj) { f32x4 v0 = acc[ai][bj][m][0], v1 = acc[ai][bj][m][1];
                        if (rope) { f32x4 o0, o1;
#pragma unroll
                            for (int i = 0; i < 4; ++i) { o0[i] = __shfl_xor(v0[i], 16); o1[i] = __shfl_xor(v1[i], 16); }
                            if (fq < 2) { v0 = v0 * cs[m][0] + o0 * cs[m][2]; v1 = v1 * cs[m][1] + o1 * cs[m][3]; } }
                        v0 = v0 * rsc[ai][m]; v1 = v1 * rsc[ai][m];
                        u32x4 w; w.x = cvt_pk_bf16(v0[0], v0[1]); w.y = cvt_pk_bf16(v0[2], v0[3]); w.z = cvt_pk_bf16(v1[0], v1[1]); w.w = cvt_pk_bf16(v1[2], v1[3]);
                        *(u32x4*)(rowp + bj * HALF) = w; } } }
        } else {
#pragma unroll
            for (int ai = 0; ai < 2; ++ai)
#pragma unroll
                for (int m = 0; m < 4; ++m) { const size_t row = (size_t)(row0 + ai * HALF + m * 16);
#pragma unroll
                    for (int bj = 0; bj < 2; ++bj) { const int lc = bj * HALF + lc0; f32x4 v0 = acc[ai][bj][m][0], v1 = acc[ai][bj][m][1];
                        float* dst = nullptr;
                        if (lc < 64) dst = (float*)(ws + WS_IKRAW) + row * 64 + lc;
                        else if (lc == 64) dst = (float*)(ws + WS_FLG) + row * 8;
                        else if (lc == 72) { dst = (float*)(ws + WS_IW) + row * 8; v0 = v0 * IDX_SCALE; v1 = v1 * IDX_SCALE; }
                        if (dst) { *(f32x4*)dst = v0; *(f32x4*)(dst + 4) = v1; } } }
        }
    }
};
struct EpiYb {
    static constexpr bool PERM = true, AFTER_DRAIN = false;
    bf16_t* Y;
    __device__ __forceinline__ void operator()(const f32x4 (&acc)[2][2][4][2], const Unit& u, int wr, int wc, int fr, int fq) const {
        const int row0 = u.pm * BM + wr * 64 + fr; bf16_t* base = Y + u.pn * BM + wc * 32 + 8 * fq;
#pragma unroll
        for (int ai = 0; ai < 2; ++ai)
#pragma unroll
            for (int m = 0; m < 4; ++m) { bf16_t* rowp = base + (size_t)(row0 + ai * HALF + m * 16) * 1024;
#pragma unroll
                for (int bj = 0; bj < 2; ++bj) { const f32x4 v0 = acc[ai][bj][m][0], v1 = acc[ai][bj][m][1];
                    u32x4 w; w.x = cvt_pk_bf16(v0[0], v0[1]); w.y = cvt_pk_bf16(v0[2], v0[3]); w.z = cvt_pk_bf16(v1[0], v1[1]); w.w = cvt_pk_bf16(v1[2], v1[3]);
                    *(u32x4*)(rowp + bj * HALF) = w; } }
    }
};
}

__device__ __forceinline__ float wave_incl_scan_f(float x) {
#define WSF_STEP(ctrl, rm, bc) x += __builtin_bit_cast(float, __builtin_amdgcn_update_dpp(0, __builtin_bit_cast(int, x), ctrl, rm, 0xF, bc))
    WSF_STEP(0x111, 0xF, true); WSF_STEP(0x112, 0xF, true); WSF_STEP(0x114, 0xF, true); WSF_STEP(0x118, 0xF, true); WSF_STEP(0x142, 0xA, false); WSF_STEP(0x143, 0xC, false);
#undef WSF_STEP
    return x;
}
__device__ __forceinline__ void p2_post(const Prm& P, LAS unsigned char* lds, int vcu, int G) {
    const int tid = opaque_tid(), lane = tid & 63, wave = tid >> 6;
    unsigned char* ws = P.ws;
    if (G == 256 ? (vcu & 31) < 16 : vcu < NB * 8) {
        const int b = G == 256 ? 2 * (vcu >> 5) + ((vcu & 31) >> 3) : vcu >> 3, h = vcu & 7;
        const float* FLG = (const float*)(ws + WS_FLG) + (size_t)b * SEQ * 8 + h; float* FL = (float*)(ws + WS_FL) + ((size_t)b * 8 + h) * SEQ;
        const float bf = P.b_forget[h];
        LAS float* part = (LAS float*)lds;
        float vals[8];
#pragma unroll
        for (int i = 0; i < 8; ++i) vals[i] = FLG[(size_t)(512 * wave + 64 * i + lane) * 8];
        float carry = 0.f;
#pragma unroll
        for (int i = 0; i < 8; ++i) { vals[i] = carry + wave_incl_scan_f(LOG2E * log_sigmoid(vals[i] + bf)); carry = __builtin_bit_cast(float, __builtin_amdgcn_readlane(__builtin_bit_cast(int, vals[i]), 63)); }
        if (lane == 0) part[wave] = carry;
        __syncthreads();
        float off = 0.f;
#pragma unroll
        for (int w = 0; w < 7; ++w) off += w < wave ? part[w] : 0.f;
#pragma unroll
        for (int i = 0; i < 8; ++i) FL[512 * wave + 64 * i + lane] = -(off + vals[i]);
    }
    const int gw = vcu * NWAVES + wave, NGW = G * NWAVES;
    const int rb = G == 256 ? 8192 * (vcu >> 5) : 0, Ml = G == 256 ? 8192 : M, gwl = G == 256 ? (vcu & 31) * NWAVES + wave : gw, NGl = G == 256 ? 32 * NWAVES : NGW;
    bf16* QQ = (bf16*)(ws + WS_QQ); bf16* KK = (bf16*)(ws + WS_KK); bf16* IQ = (bf16*)(ws + WS_IQ); bf16* IK = (bf16*)(ws + WS_IK);
    const float* IKRAW = (const float*)(ws + WS_IKRAW); float* IW = (float*)(ws + WS_IW);
    const float* COS = (const float*)(ws + WS_COS); const float* SIN = (const float*)(ws + WS_SIN);
    const float ikg = P.ikg[lane], ikb = P.ikb[lane];
    {
      unsigned* KMAX = (unsigned*)(ws + WS_CTL) + CW_KMAX; const int head = lane >> 3, part = lane & 7;
      for (int ml0 = gwl * 32; ml0 < Ml; ml0 += NGl * 32) { const int m0 = rb + ml0; float mx = 0.f;
        _Pragma("unroll 1") for (int k0 = 0; k0 < 32; k0 += 16) { u32x4 vv[16];
#pragma unroll
          for (int k = 0; k < 16; ++k) vv[k] = *(const u32x4*)(KK + (size_t)(m0 + k0 + k) * 1024 + head * 64 + part * 8);
#pragma unroll
          for (int k = 0; k < 16; ++k) { const u32x4 v = vv[k]; float sq = 0.f;
#pragma unroll
            for (int i = 0; i < 4; ++i) { const float a = bf2f(v[i] & 0xFFFFu), c2 = bf2f(v[i] >> 16); sq += a * a + c2 * c2; }
            sq += __shfl_xor(sq, 1); sq += __shfl_xor(sq, 2); sq += __shfl_xor(sq, 4); mx = fmaxf(mx, sq); } }
        if (part == 0) atomicMax(&KMAX[(m0 >> 12) * 8 + head], __float_as_uint(mx)); } }
    for (int ml16 = gwl * 32; ml16 < Ml; ml16 += NGl * 32) { const int m16 = rb + ml16;
        const int head = (lane >> 1) & 7, half = lane & 1;
        f32x4 c4[8], s4[8]; u32x2 a[8], b2[8];
#pragma unroll
        for (int i = 0; i < 8; ++i) { const int m = m16 + 4 * i + (lane >> 4); const bf16* p = KK + (size_t)m * 1024 + 512 + head * 64 + 4 * half;
            c4[i] = *(const f32x4*)(COS + (size_t)m * 8 + 4 * half); s4[i] = *(const f32x4*)(SIN + (size_t)m * 8 + 4 * half); a[i] = *(const u32x2*)p; b2[i] = *(const u32x2*)(p + 8); }
#pragma unroll
        for (int i = 0; i < 8; ++i) { const int m = m16 + 4 * i + (lane >> 4); bf16* p = KK + (size_t)m * 1024 + 512 + head * 64 + 4 * half;
            const f32x4 t1 = {bf2f(a[i].x & 0xFFFFu), bf2f(a[i].x >> 16), bf2f(a[i].y & 0xFFFFu), bf2f(a[i].y >> 16)}, t2 = {bf2f(b2[i].x & 0xFFFFu), bf2f(b2[i].x >> 16), bf2f(b2[i].y & 0xFFFFu), bf2f(b2[i].y >> 16)};
            const f32x4 o1 = t1 * c4[i] - t2 * s4[i], o2 = t2 * c4[i] + t1 * s4[i];
            *(u32x2*)p = (u32x2){pk2(o1[0], o1[1]), pk2(o1[2], o1[3])}; *(u32x2*)(p + 8) = (u32x2){pk2(o2[0], o2[1]), pk2(o2[2], o2[3])}; }
    }
    for (int mm = gwl; mm < Ml; mm += 8 * NGl) {
        int mr[8]; float c[8], s[8], v[8];
#pragma unroll
        for (int i = 0; i < 8; ++i) { mr[i] = rb + (mm + i * NGl < Ml ? mm + i * NGl : mm); c[i] = COS[(size_t)mr[i] * 8 + (lane & 7)]; s[i] = SIN[(size_t)mr[i] * 8 + (lane & 7)]; v[i] = IKRAW[(size_t)mr[i] * 64 + lane]; }
#pragma unroll
        for (int i = 0; i < 8; ++i) {
            const float mean = wave_sum(v[i]) * (1.f / 64.f); const float xc = v[i] - mean;
            const float var = wave_sum(xc * xc) * (1.f / 64.f);
            float y = xc * (1.0f / sqrtf(var + LN_EPS)) * ikg + ikb;
            const float other = __shfl_xor(y, 8);
            if (lane < 8) y = y * c[i] - other * s[i]; else if (lane < 16) y = y * c[i] + other * s[i];
            IK[(size_t)mr[i] * 64 + lane] = (bf16)f2bf(y); }
    }
}

constexpr int IX_HIST = 0, IX_IQS = 65536, IX_IQ_PITCH = 1040, IX_SELB = IX_IQS + 32 * IX_IQ_PITCH, IX_CB = IX_SELB + 16384, IX_CC = IX_CB + 16384, IX_INFO = IX_CC + 8192;
constexpr int IX_WQ = IX_INFO + 512, IX_STG2 = IX_WQ + 1024;
constexpr int IX_LIST = IX_HIST, IX_CNT = IX_CC, IX_CAP = 512, IX_RH = IX_CB;
static_assert(IX_STG2 + 16384 <= MISC_OFF, "indexer LDS map");
__device__ __forceinline__ unsigned ordered_key(float f) { const unsigned u = __builtin_bit_cast(unsigned, f); return u ^ ((u >> 31) ? 0xFFFFFFFFu : 0x80000000u); }
__device__ __forceinline__ int win_bin(float f) {
    const unsigned u = __builtin_bit_cast(unsigned, f); const int a = (int)(u & 0x7FFFFFFFu);
    int m = (a - 0x3A800000 + (1 << 18)) >> 18; m = m < 0 ? 0 : m > 481 ? 481 : m;
    return (m ^ ((int)u >> 31)) + 512;
}
__device__ __forceinline__ int wave_incl_scan(int x) {
    x += __builtin_amdgcn_update_dpp(0, x, 0x111, 0xF, 0xF, true);
    x += __builtin_amdgcn_update_dpp(0, x, 0x112, 0xF, 0xF, true);
    x += __builtin_amdgcn_update_dpp(0, x, 0x114, 0xF, 0xF, true);
    x += __builtin_amdgcn_update_dpp(0, x, 0x118, 0xF, 0xF, true);
    x += __builtin_amdgcn_update_dpp(0, x, 0x142, 0xA, 0xF, false);
    x += __builtin_amdgcn_update_dpp(0, x, 0x143, 0xC, 0xF, false);
    return x;
}
__device__ __forceinline__ void find_bucket2(const LAS unsigned* hrow, int needA, int needB, int lane, int& binA, int& binB) {
    const int lr = 63 - lane;
    unsigned w[8];
#pragma unroll
    for (int j = 0; j < 8; ++j) w[j] = hrow[8 * lr + j];
    int tot = 0;
#pragma unroll
    for (int j = 0; j < 8; ++j) tot += (int)(w[j] & 0xFFFFu) + (int)(w[j] >> 16);
    const int S = wave_incl_scan(tot) - tot;
    int ba = -1, bb = -1;
    if (S < needB && S + tot >= needA) {
        int acc = S;
#pragma unroll
        for (int i = 15; i >= 0; --i) { const int cnt = (i & 1) ? (int)(w[i >> 1] >> 16) : (int)(w[i >> 1] & 0xFFFFu);
            if (acc < needA && acc + cnt >= needA) ba = 16 * lr + i;
            if (acc < needB && acc + cnt >= needB) bb = 16 * lr + i;
            acc += cnt; }
    }
    const unsigned long long balA = __ballot(ba >= 0), balB = __ballot(bb >= 0);
    binA = __builtin_amdgcn_readlane(ba, balA ? (int)__builtin_ctzll(balA) : 0); binB = __builtin_amdgcn_readlane(bb, balB ? (int)__builtin_ctzll(balB) : 0);
}
__device__ __forceinline__ void find_bucket(const LAS unsigned* hrow, int need, int lane, int& bin_out, int& above_out) {
    const int lr = 63 - lane;
    unsigned w[8];
#pragma unroll
    for (int j = 0; j < 8; ++j) w[j] = hrow[8 * lr + j];
    int tot = 0;
#pragma unroll
    for (int j = 0; j < 8; ++j) tot += (int)(w[j] & 0xFFFFu) + (int)(w[j] >> 16);
    const int S = wave_incl_scan(tot) - tot;
    int bin = -1, above = 0;
    if (S < need && S + tot >= need) {
        int acc = S; bool done = false;
#pragma unroll
        for (int i = 15; i >= 0; --i) { const int cnt = (i & 1) ? (int)(w[i >> 1] >> 16) : (int)(w[i >> 1] & 0xFFFFu);
            if (!done) { if (acc + cnt >= need) { bin = 16 * lr + i; above = acc; done = true; } else acc += cnt; } }
    }
    const unsigned long long bal = __ballot(bin >= 0);
    const int src = bal ? (int)__builtin_ctzll(bal) : 0;
    bin_out = __builtin_amdgcn_readlane(bin, src); above_out = __builtin_amdgcn_readlane(above, src);
}
#ifndef IX_UNROLL
#define IX_UNROLL 4
#endif
__device__ __forceinline__ float relu_s(float x) { const int i = __builtin_bit_cast(int, x); return __builtin_bit_cast(float, i > 0 ? i : 0); }
template <bool HALF>
__device__ __forceinline__ void ix_scores(f32x16& sc0, f32x16& sc1, const bf16x8 (&kf)[4][2], const LAS unsigned char* iqrow, const LAS float* wq) {
    sc0 = f32x16{}; sc1 = f32x16{};
#pragma unroll IX_UNROLL
    for (int h = 0; h < 8; ++h) {
        const float wqh = wq[h];
        bf16x8 qf[4];
#pragma unroll
        for (int d0 = 0; d0 < 4; ++d0) qf[d0] = *(const LAS bf16x8*)(iqrow + (h * 4 + d0) * 1024);
        f32x16 x0 = f32x16{}, x1 = f32x16{};
#pragma unroll
        for (int d0 = 0; d0 < 4; ++d0) { x0 = __builtin_amdgcn_mfma_f32_32x32x16_bf16(kf[d0][0], qf[d0], x0, 0, 0, 0);
            if (!HALF) x1 = __builtin_amdgcn_mfma_f32_32x32x16_bf16(kf[d0][1], qf[d0], x1, 0, 0, 0); }
#pragma unroll
        for (int r = 0; r < 16; ++r) { const float rx = relu_s(x0[r]); asm("v_fmac_f32_e32 %0, %1, %2" : "+v"(sc0[r]) : "v"(wqh), "v"(rx)); }
        if (!HALF) {
#pragma unroll
            for (int r = 0; r < 16; ++r) { const float rx = relu_s(x1[r]); asm("v_fmac_f32_e32 %0, %1, %2" : "+v"(sc1[r]) : "v"(wqh), "v"(rx)); }
        }
    }
}
__device__ __forceinline__ unsigned bin_key_lo(int b) {
    if (b <= 30) return 0u;
    if (b >= 994) return 0xFFFFFFFFu;
    if (b >= 512) { const int m = b - 512; return 0x80000000u + (m == 0 ? 0u : 0x3A800000u + ((unsigned)(m - 1) << 18)); }
    return 0x80000000u - (0x3A800000u + ((unsigned)(511 - b) << 18));
}
__device__ __forceinline__ unsigned key_to_float_bits(unsigned k) {
    if (k == 0u) return 0xFF800000u;
    if (k == 0xFFFFFFFFu) return 0x7F800000u;
    return k ^ ((k >> 31) ? 0x80000000u : 0xFFFFFFFFu);
}
template <bool HALF>
__device__ __forceinline__ void ix_load_k(bf16x8 (&kf)[4][2], const bf16* IK, int b, int row0, int stride, int r32, int hi) {
    const bf16* kp = IK + (size_t)(b * SEQ + row0 + stride * r32) * 64 + 8 * hi;
#pragma unroll
    for (int d0 = 0; d0 < 4; ++d0) { kf[d0][0] = *(const bf16x8*)(kp + 16 * d0); kf[d0][1] = HALF ? kf[d0][0] : *(const bf16x8*)(kp + 32 * 64 + 16 * d0); }
}
template <int MODE>
__device__ __forceinline__ void ix_first_k(bf16x8 (&kf)[4][2], const bf16* IK, int b, int c, int tid) {
    const int lane = tid & 63, t = tid >> 6, r32_ = lane & 31, hi_ = lane >> 5;
    const int nit = MODE == 5 ? (c + 2) >> 1 : c + 1;
    const bool pair = MODE == 5 && 2 * t + 1 <= c;
    if (t < nit) ix_load_k<MODE == 5>(kf, IK, b, MODE == 5 ? 128 * t + (pair ? (t & 3) : 0) : 64 * t, pair ? 4 : 1, r32_, hi_);
}
template <int MODE, bool PRE = false>
__device__ __forceinline__ void ix_pass(LAS unsigned char* lds, const bf16* IK, int b, int c, int tid, bf16x8 (&kf)[4][2]) {
    const int lane = tid & 63, wave = tid >> 6, r32_ = lane & 31, hi_ = lane >> 5;
    LAS unsigned* hist = (LAS unsigned*)(lds + IX_HIST);
    LAS unsigned long long* selb = (LAS unsigned long long*)(lds + IX_SELB);
    LAS unsigned long long* cb = (LAS unsigned long long*)(lds + IX_CB);
    LAS int* cc = (LAS int*)(lds + IX_CC);
    LAS int* info = (LAS int*)(lds + IX_INFO);
    LAS unsigned* list = (LAS unsigned*)(lds + IX_LIST); LAS int* cnt = (LAS int*)(lds + IX_CNT);
    const LAS unsigned char* iqrow = lds + IX_IQS + (hi_ * 32 + r32_) * 16;
    const LAS float* wqp = (const LAS float*)(lds + IX_WQ) + r32_ * 8;
    const int rb = info[r32_];
    const int rc = info[32 + r32_];
    const int t20 = info[64 + r32_];
    const int nit = MODE == 5 ? (c + 2) >> 1 : c + 1;
    for (int t = wave; t < nit; t += NWAVES) {
        f32x16 sc0, sc1;
        const bool pair = MODE == 5 && 2 * t + 1 <= c;
        { if (!PRE || t != wave) ix_load_k<MODE == 5>(kf, IK, b, MODE == 5 ? 128 * t + (pair ? (t & 3) : 0) : 64 * t, pair ? 4 : 1, r32_, hi_);
          ix_scores<MODE == 5>(sc0, sc1, kf, iqrow, wqp); }
        unsigned sw0 = 0u, sw1 = 0u, cw0 = 0u, cw1 = 0u;
        int r32 = r32_, hi = hi_; asm volatile("" : "+v"(r32), "+v"(hi));
        if (MODE == 6) {
            const float fsel = __int_as_float(rb), fcand = __int_as_float(rc);
            unsigned a0 = 0u, a1 = 0u, b0 = 0u, b1 = 0u;
#pragma unroll
            for (int r = 15; r >= 0; --r) {
                a0 = __builtin_amdgcn_alignbit(a0, __float_as_uint(sc0[r] - fsel), 31); a1 = __builtin_amdgcn_alignbit(a1, __float_as_uint(sc1[r] - fsel), 31);
                b0 = __builtin_amdgcn_alignbit(b0, __float_as_uint(sc0[r] - fcand), 31); b1 = __builtin_amdgcn_alignbit(b1, __float_as_uint(sc1[r] - fcand), 31);
            }
#define IX_SPREAD(x) ({ unsigned y_ = (~(x)) & 0xFFFFu; y_ = (y_ | (y_ << 8)) & 0x00FF00FFu; (y_ | (y_ << 4)) & 0x0F0F0F0Fu; })
            sw0 = IX_SPREAD(a0); sw1 = IX_SPREAD(a1); cw0 = IX_SPREAD(b0) & ~sw0; cw1 = IX_SPREAD(b1) & ~sw1;
#undef IX_SPREAD
        }
#pragma unroll
        for (int r = 0; r < 16; ++r) {
            if (MODE == 6) break;
#pragma unroll
            for (int hh = 0; hh < 2; ++hh) {
                const float sc = hh ? sc1[r] : sc0[r];
                const int cp = (r & 3) + 8 * (r >> 2);
                if (MODE == 5) { if (hh == 0 && ((r & 1) == 0 || pair)) { const unsigned bin = (unsigned)win_bin(sc); atomicAdd((unsigned*)&hist[r32 * 512 + (bin >> 1)], 1u << (16 * (bin & 1))); } }
                if (MODE == 1) { const unsigned bin = ordered_key(sc) >> 22; atomicAdd((unsigned*)&hist[r32 * 512 + (bin >> 1)], 1u << (16 * (bin & 1))); }
                if (MODE == 2) { const unsigned k = ordered_key(sc); if ((int)(k >> 22) == rb) { const unsigned bin = (k >> 12) & 1023u; atomicAdd((unsigned*)&hist[r32 * 512 + (bin >> 1)], 1u << (16 * (bin & 1))); } }
                if (MODE == 4) { const int pf = (int)(ordered_key(sc) >> 12); const unsigned s = pf > t20 ? 1u : 0u, cnd = pf == t20 ? 1u : 0u;
                    if (hh) { sw1 |= s << cp; cw1 |= cnd << cp; } else { sw0 |= s << cp; cw0 |= cnd << cp; } }
            }
            __builtin_amdgcn_sched_barrier(0);
        }
        if (MODE == 6) {
            int base = 0;
            { const int nc = __popc(cw0) + __popc(cw1);
              if (nc > 0) { base = atomicAdd((int*)&cnt[r32], nc); if (base + nc > IX_CAP) { cnt[32] = 1; cw0 = 0u; cw1 = 0u; } } }
            LAS float* stg = (LAS float*)(lds + (wave < 4 ? IX_CB + wave * 4096 : IX_STG2 + (wave - 4) * 4096)) + lane;
            LAS unsigned* lp = list + r32 * IX_CAP + base;
#pragma unroll
            for (int hh = 0; hh < 2; ++hh) {
#pragma unroll
                for (int r = 0; r < 16; ++r) stg[64 * r] = hh ? sc1[r] : sc0[r];
                unsigned w = hh ? cw1 : cw0;
                const int kb = 4095 - (64 * t + 4 * hi + 32 * hh);
                while (w != 0u) { const int cp = (int)__builtin_ctz(w); w &= w - 1u;
                    const float s = stg[64 * ((cp & 3) | ((cp >> 1) & 12))];
                    *lp++ = (ordered_key(s) & 0xFFFFF000u) | (unsigned)(kb - cp); }
            }
        }
        if (MODE == 4 || MODE == 6) {
            sw0 <<= 4 * hi; sw1 <<= 4 * hi; sw0 |= __shfl_xor(sw0, 32); sw1 |= __shfl_xor(sw1, 32);
            if (MODE == 4) { cw0 <<= 4 * hi; cw1 <<= 4 * hi; cw0 |= __shfl_xor(cw0, 32); cw1 |= __shfl_xor(cw1, 32); }
            if (hi == 0) { selb[r32 * 64 + t] = ((unsigned long long)sw1 << 32) | sw0;
                if (MODE == 4) { cb[r32 * 64 + t] = ((unsigned long long)cw1 << 32) | cw0; cc[r32 * 64 + t] = __popc(cw0) + __popc(cw1); } }
        }
    }
}
__device__ __forceinline__ void p3_indexer(const Prm& P, LAS unsigned char* lds, int vcu, int G) {
    const int tid0 = threadIdx.x;
    unsigned char* ws = P.ws;
    const bf16* IQ = (const bf16*)(ws + WS_IQ); const bf16* IK = (const bf16*)(ws + WS_IK); const float* IW = (const float*)(ws + WS_IW);
    unsigned* MASK = (unsigned*)(ws + WS_MASK);
    LAS unsigned* hist = (LAS unsigned*)(lds + IX_HIST);
    LAS unsigned long long* selb = (LAS unsigned long long*)(lds + IX_SELB);
    LAS unsigned long long* cb = (LAS unsigned long long*)(lds + IX_CB);
    LAS int* cc = (LAS int*)(lds + IX_CC);
    LAS int* info = (LAS int*)(lds + IX_INFO);
    LAS unsigned* list = (LAS unsigned*)(lds + IX_LIST); LAS int* cnt = (LAS int*)(lds + IX_CNT);
    const int NUN = NB * 64 * 2;
#define IX_TID(name) int name; { int z_ = 0; asm volatile("" : "+s"(z_)); name = tid0 + z_; }
#define IX_CLEAR_HIST() do { IX_TID(t_); for (int i = t_; i < 32 * 512; i += NTHR) hist[i] = 0u; } while (0)
#define IX_BUCKETS(FAST, SECOND) do { IX_TID(t_); const int lane_ = t_ & 63, wave_ = t_ >> 6; \
        _Pragma("unroll 1") for (int k = 0; k < 4; ++k) { const int row = wave_ * 4 + k; const int need = (SECOND) ? info[32 + row] : TOPK; int bin, above; find_bucket(hist + row * 512, need, lane_, bin, above); \
            if (lane_ == 0) { if (SECOND) { info[64 + row] = (info[row] << 10) | bin; info[96 + row] = need - above; } else { info[row] = bin; info[32 + row] = need - above; \
                if ((FAST) && (bin <= 30 || bin == 511 || bin == 512 || bin >= 993)) cnt[32] = 1; } } } } while (0)
    for (int u0 = vcu; u0 < NUN; u0 += G) {
        int b, c, half;
        if (G == 256) { const int s = (vcu & 31) + 32 * (u0 >> 8);
            c = 63 - (s >> 2); b = 2 * (vcu >> 5) + ((s >> 1) & 1); half = s & 1; }
        else { const int u = NUN - 1 - u0; b = u & 15; const int rem = u >> 4; c = rem >> 1; half = rem & 1; }
        const int m0 = b * SEQ + 64 * c + 32 * half;
        if (c < 4) {
            for (int i = tid0; i < 32 * 2 * (c + 1); i += NTHR) { const int q = i / (2 * (c + 1)), w = i % (2 * (c + 1)); MASK[(size_t)(m0 + q) * 128 + w] = 0xFFFFFFFFu; }
            continue;
        }
        __syncthreads();
        DIAG_T0(P);
        bf16x8 kfp[4][2];
        { IX_TID(t_); ix_first_k<5>(kfp, IK, b, c, t_); }
        { IX_TID(t_);
          const int row = t_ & 31, chb = t_ >> 5;
          u32x4 own[4];
#pragma unroll
          for (int k = 0; k < 4; ++k) own[k] = *(const u32x4*)(IQ + (size_t)(m0 + row) * 512 + (chb + 16 * k) * 8);
          if ((chb & 7) < 2) {
              const float* cp = (const float*)(ws + WS_COS) + (size_t)(m0 + row) * 8; const float* sp = (const float*)(ws + WS_SIN) + (size_t)(m0 + row) * 8;
              const f32x4 c0 = *(const f32x4*)cp, c1 = *(const f32x4*)(cp + 4), s0 = *(const f32x4*)sp, s1 = *(const f32x4*)(sp + 4);
              const float sg = (chb & 1) ? 1.f : -1.f;
#pragma unroll
              for (int k = 0; k < 4; ++k) { u32x4 oth;
#pragma unroll
                for (int i = 0; i < 4; ++i) oth[i] = __shfl_xor(own[k][i], 32);
#pragma unroll
                for (int i = 0; i < 4; ++i) { const float cA = i < 2 ? c0[2 * i] : c1[2 * i - 4], cB = i < 2 ? c0[2 * i + 1] : c1[2 * i - 3], sA = i < 2 ? s0[2 * i] : s1[2 * i - 4], sB = i < 2 ? s0[2 * i + 1] : s1[2 * i - 3];
                    const float a = bf2f(own[k][i] & 0xFFFFu) * cA + sg * bf2f(oth[i] & 0xFFFFu) * sA, b2 = bf2f(own[k][i] >> 16) * cB + sg * bf2f(oth[i] >> 16) * sB; own[k][i] = pk2(a, b2); } }
          }
#pragma unroll
          for (int k = 0; k < 4; ++k) *(LAS u32x4*)(lds + IX_IQS + ((chb + 16 * k) * 32 + row) * 16) = own[k];
          if (t_ < 256) ((LAS float*)(lds + IX_WQ))[t_] = IW[(size_t)m0 * 8 + t_];
          if (t_ < 64) cnt[t_] = 0; }
        IX_CLEAR_HIST();
        __syncthreads();
        DIAG_ACC(P, 0);
#if defined(IX_SELFTEST)
        bool fast_ok = (u0 % 509) != 0;
#else
        bool fast_ok = true;
#endif
        if (fast_ok) {
            { IX_TID(t_); ix_pass<5, true>(lds, IK, b, c, t_, kfp); }
            { IX_TID(t_); ix_first_k<6>(kfp, IK, b, c, t_); }
            __syncthreads();
            DIAG_ACC(P, 1);
            { IX_TID(t_); const int lane_ = t_ & 63, wave_ = t_ >> 6; const int ns = 16 * (c + 1);
              _Pragma("unroll 1") for (int k = 0; k < 4; ++k) { const int row = wave_ * 4 + k; int bhi, blo, ab;
                if (100 < ns) find_bucket2(hist + row * 512, 28, 100, lane_, bhi, blo); else { find_bucket(hist + row * 512, 28, lane_, bhi, ab); blo = 0; }
                if (lane_ == 0) { info[row] = (int)key_to_float_bits(bin_key_lo(bhi + 1)); info[32 + row] = (int)key_to_float_bits(100 < ns ? bin_key_lo(blo) : 0u); } } }
            __syncthreads();
            DIAG_ACC(P, 2);
            { IX_TID(t_); ix_pass<6, true>(lds, IK, b, c, t_, kfp); }
            __syncthreads();
            DIAG_ACC(P, 3);
            { IX_TID(t_); const int lane_ = t_ & 63, wave_ = t_ >> 6; LAS unsigned* selw = (LAS unsigned*)selb;
              _Pragma("unroll 1") for (int k = 0; k < 4; k += 2) {
                unsigned v[2][8]; unsigned T[2]; int need[2]; bool same[2];
#pragma unroll
                for (int i = 0; i < 2; ++i) { const int row = wave_ * 4 + k + i;
                    int above = lane_ <= c ? __popcll(selb[row * 64 + lane_]) : 0;
                    above = __builtin_amdgcn_readlane(wave_incl_scan(above), 63);
                    int n = cnt[row]; need[i] = TOPK - above;
                    if (need[i] < 1 || need[i] > n || n > IX_CAP) { if (lane_ == 0) cnt[32] = 1; n = 0; need[i] = 1; }
#pragma unroll
                    for (int j = 0; j < 8; ++j) v[i][j] = (lane_ + 64 * j) < n ? list[row * IX_CAP + lane_ + 64 * j] : 0u;
                    T[i] = (unsigned)__builtin_amdgcn_readfirstlane((int)v[i][0]) & 0xFF000000u;
                    bool diff = false;
#pragma unroll
                    for (int j = 0; j < 8; ++j) diff |= v[i][j] != 0u && ((v[i][j] ^ T[i]) >> 24) != 0u;
                    same[i] = __ballot(diff) == 0ull; }
                const bool skip0 = same[0] && same[1];
                if (!skip0) { T[0] = 0u; T[1] = 0u; }
                LAS unsigned* rh = (LAS unsigned*)(lds + IX_RH) + wave_ * 512;
#pragma unroll
                for (int step = 0; step < 4; ++step) { const int shift = 24 - 8 * step;
                    if (step == 0 && skip0) continue;
                    const int lr = 63 - lane_;
                    u32x4 hh[2];
#pragma unroll
                    for (int i = 0; i < 2; ++i) *(LAS u32x4*)(rh + 256 * i + 4 * lane_) = (u32x4){0u, 0u, 0u, 0u};
#pragma unroll
                    for (int i = 0; i < 2; ++i) {
#pragma unroll
                        for (int j = 0; j < 8; ++j) { const unsigned x = v[i][j];
                            const bool act = x != 0u && (step == 0 || ((x ^ T[i]) >> (shift + 8 < 32 ? shift + 8 : 31)) == 0u);
                            if (act) atomicAdd((unsigned*)&rh[256 * i + ((x >> shift) & 255u)], 1u); } }
#pragma unroll
                    for (int i = 0; i < 2; ++i) hh[i] = *(const LAS u32x4*)(rh + 256 * i + 4 * lr);
#pragma unroll
                    for (int i = 0; i < 2; ++i) {
                        const int tot = (int)(hh[i][0] + hh[i][1] + hh[i][2] + hh[i][3]);
                        const int incl = wave_incl_scan(tot), excl = incl - tot, nd = need[i];
                        int bin = -1, ab = 0;
                        if (excl < nd && incl >= nd) {
                            int acc = excl;
                            if (acc + (int)hh[i][3] >= nd) { bin = 3; ab = acc; } else { acc += (int)hh[i][3];
                            if (acc + (int)hh[i][2] >= nd) { bin = 2; ab = acc; } else { acc += (int)hh[i][2];
                            if (acc + (int)hh[i][1] >= nd) { bin = 1; ab = acc; } else { acc += (int)hh[i][1]; bin = 0; ab = acc; } } }
                            bin += 4 * lr; }
                        const unsigned long long bal = __ballot(bin >= 0);
                        const int src = bal ? (int)__builtin_ctzll(bal) : 0;
                        bin = __builtin_amdgcn_readlane(bin, src); ab = __builtin_amdgcn_readlane(ab, src);
                        T[i] |= (unsigned)bin << shift; need[i] -= ab; } }
#pragma unroll
                for (int i = 0; i < 2; ++i) { const int row = wave_ * 4 + k + i;
#pragma unroll
                    for (int j = 0; j < 8; ++j) if (v[i][j] >= T[i] && v[i][j] != 0u) { const int idx = 4095 - (int)(v[i][j] & 4095u); atomicOr((unsigned*)&selw[row * 128 + (idx >> 5)], 1u << (idx & 31)); } }
              } }
            __syncthreads();
            DIAG_ACC(P, 4);
            fast_ok = cnt[32] == 0;
            if (fast_ok) {
                IX_TID(t_);
                _Pragma("unroll 1") for (int k = 0; k < 4; ++k) { const int id = t_ + NTHR * k, q = id >> 6, t = id & 63;
                    if (t <= c) { const unsigned long long outw = selb[q * 64 + t]; *(u32x2*)(MASK + (size_t)(m0 + q) * 128 + 2 * t) = (u32x2){(unsigned)outw, (unsigned)(outw >> 32)}; } }
            }
        }
        DIAG_ACC(P, 5);
        if (fast_ok) continue;
        __syncthreads();
        IX_CLEAR_HIST();
        __syncthreads();
        { IX_TID(t_); ix_pass<1>(lds, IK, b, c, t_, kfp); }
        __syncthreads();
        IX_BUCKETS(false, false);
        __syncthreads();
        IX_CLEAR_HIST();
        __syncthreads();
        { IX_TID(t_); ix_pass<2>(lds, IK, b, c, t_, kfp); }
        __syncthreads();
        IX_BUCKETS(false, true);
        __syncthreads();
        { IX_TID(t_); ix_pass<4>(lds, IK, b, c, t_, kfp); }
        __syncthreads();
        { IX_TID(t_);
          if (t_ < 32) { int run = info[96 + t_];
            for (int t = 0; t <= c; ++t) { const int n = cc[t_ * 64 + t]; const int take = run < n ? run : n; cc[t_ * 64 + t] = take; run -= take; } } }
        __syncthreads();
        { IX_TID(t_);
          _Pragma("unroll 1") for (int k = 0; k < 4; ++k) { const int id = t_ + NTHR * k, q = id >> 6, t = id & 63;
            if (t <= c) { int take = cc[q * 64 + t]; unsigned long long cbw = cb[q * 64 + t], outw = selb[q * 64 + t];
                while (take > 0) { const unsigned long long low = cbw & (0ull - cbw); outw |= low; cbw ^= low; --take; }
                *(u32x2*)(MASK + (size_t)(m0 + q) * 128 + 2 * t) = (u32x2){(unsigned)outw, (unsigned)(outw >> 32)}; } } }
        DIAG_ACC(P, 6);
    }
#undef IX_TID
#undef IX_CLEAR_HIST
#undef IX_BUCKETS
}

namespace af {
typedef float f32x2_t __attribute__((ext_vector_type(2))); typedef __bf16 bf16x2_t __attribute__((ext_vector_type(2)));
constexpr int NW = 8, QBLK = 32, QB = 256, KVBLK = 64, DMP = 1024;
constexpr int NSLOT = 3, SLOTB = 8192;
constexpr int LDS_K = 0, LDS_V = NSLOT * SLOTB, LDS_WS = 2 * NSLOT * SLOTB, LDS_OST = LDS_WS + NW * 64 * 4, LDS_END = LDS_OST + NW * 4096;
constexpr int LDS_BIAS = LDS_END;
static_assert(LDS_BIAS + 16384 <= MISC_OFF, "attention LDS map");
constexpr int LDS_VOTE = LDS_BIAS + 16384;
static_assert(LDS_VOTE + 64 <= MISC_OFF, "attention LDS map");
constexpr float FLOOR = -1000.0f;
#define SBAR() __builtin_amdgcn_sched_barrier(0)
__device__ __forceinline__ void glds16(const void* gsrc, unsigned lds_dst) { unsigned keep;
  asm volatile("s_mov_b32 %0, m0\n\ts_mov_b32 m0, %2\n\ts_nop 0\n\tglobal_load_lds_dwordx4 %1, off\n\ts_mov_b32 m0, %0" : "=&s"(keep) : "v"(gsrc), "s"(lds_dst) : "memory"); }
__device__ __forceinline__ void glds4(const void* gsrc, unsigned lds_dst) { unsigned keep;
  asm volatile("s_mov_b32 %0, m0\n\ts_mov_b32 m0, %2\n\ts_nop 0\n\tglobal_load_lds_dword %1, off\n\ts_mov_b32 m0, %0" : "=&s"(keep) : "v"(gsrc), "s"(lds_dst) : "memory"); }
__device__ __forceinline__ void glds16s(const void* sbase, unsigned voff, unsigned lds_dst) { unsigned keep;
  asm volatile("s_mov_b32 %0, m0\n\ts_mov_b32 m0, %3\n\ts_nop 0\n\tglobal_load_lds_dwordx4 %1, %2\n\ts_mov_b32 m0, %0" : "=&s"(keep) : "v"(voff), "s"(sbase), "s"(lds_dst) : "memory"); }
__device__ __forceinline__ void glds4s(const void* sbase, unsigned voff, unsigned lds_dst) { unsigned keep;
  asm volatile("s_mov_b32 %0, m0\n\ts_mov_b32 m0, %3\n\ts_nop 0\n\tglobal_load_lds_dword %1, %2\n\ts_mov_b32 m0, %0" : "=&s"(keep) : "v"(voff), "s"(sbase), "s"(lds_dst) : "memory"); }
__device__ __forceinline__ float max3f(float a, float b, float c) { float r; asm("v_max3_f32 %0, %1, %2, %3" : "=v"(r) : "v"(a), "v"(b), "v"(c)); return r; }
__device__ __forceinline__ float max2f(float a, float b) { float r; asm("v_max_f32_e32 %0, %1, %2" : "=v"(r) : "v"(a), "v"(b)); return r; }
__device__ __forceinline__ float fadd_s(float a, float b) { float r; asm("v_add_f32_e32 %0, %1, %2" : "=v"(r) : "v"(a), "v"(b)); return r; }
__device__ __forceinline__ float fsub_s(float a, float b) { float r; asm("v_sub_f32_e32 %0, %1, %2" : "=v"(r) : "v"(a), "v"(b)); return r; }
__device__ __forceinline__ unsigned cvtpk_s(float lo, float hi) { f32x2_t v = {lo, hi}; bf16x2_t b = __builtin_convertvector(v, bf16x2_t); return __builtin_bit_cast(unsigned, b); }
#define WAIT_BAR(N) asm volatile("s_waitcnt vmcnt(" #N ") lgkmcnt(0)\n\ts_barrier" ::: "memory")
template <bool FROM_P>
__device__ __forceinline__ void qkt(f32x16& p0, f32x16& p1, const char* Kslot, const bf16x8* qr, const f32x16& negm, int r32, int hi) {
  const char* kb = Kslot + hi * 1024 + r32 * 16;
#pragma unroll
  for (int d0 = 0; d0 < 4; ++d0) {
    const bf16x8 b0 = *reinterpret_cast<const bf16x8*>(kb + d0 * 2048);
    const bf16x8 b1 = *reinterpret_cast<const bf16x8*>(kb + d0 * 2048 + 512);
    if (d0 == 0 && !FROM_P) { p0 = __builtin_amdgcn_mfma_f32_32x32x16_bf16(b0, qr[0], negm, 0, 0, 0); p1 = __builtin_amdgcn_mfma_f32_32x32x16_bf16(b1, qr[0], negm, 0, 0, 0); }
    else { p0 = __builtin_amdgcn_mfma_f32_32x32x16_bf16(b0, qr[d0], p0, 0, 0, 0); p1 = __builtin_amdgcn_mfma_f32_32x32x16_bf16(b1, qr[d0], p1, 0, 0, 0); } }
}
typedef __attribute__((address_space(3))) const char* lds_cptr;
typedef short v4i16_t __attribute__((ext_vector_type(4)));
__device__ __forceinline__ void kload8(bf16x8* kf, lds_cptr kp) {
  kf[0] = *(const LAS bf16x8*)(kp);        kf[1] = *(const LAS bf16x8*)(kp + 512);
  kf[2] = *(const LAS bf16x8*)(kp + 2048); kf[3] = *(const LAS bf16x8*)(kp + 2560);
  kf[4] = *(const LAS bf16x8*)(kp + 4096); kf[5] = *(const LAS bf16x8*)(kp + 4608);
  kf[6] = *(const LAS bf16x8*)(kp + 6144); kf[7] = *(const LAS bf16x8*)(kp + 6656);
}
__device__ __forceinline__ void kload2(bf16x8* kf, lds_cptr kp, int j) { kf[2 * j] = *(const LAS bf16x8*)(kp + j * 2048); kf[2 * j + 1] = *(const LAS bf16x8*)(kp + j * 2048 + 512); }
__device__ __forceinline__ s16x4 vtr(lds_cptr p) { return __builtin_bit_cast(s16x4, __builtin_amdgcn_ds_read_tr16_b64_v4i16((LAS v4i16_t*)p)); }
__device__ __forceinline__ float rowmax(const f32x16& p0, const f32x16& p1) {
  float a = max3f(p0[0], p0[1], p1[0]), b = max3f(p0[2], p0[3], p1[1]); a = max3f(a, p1[2], p1[3]);
#pragma unroll
  for (int r = 4; r < 16; r += 4) { a = max3f(a, p0[r], p0[r + 1]); b = max3f(b, p0[r + 2], p0[r + 3]); a = max3f(a, p1[r], p1[r + 1]); b = max3f(b, p1[r + 2], p1[r + 3]); }
  const float m = max2f(a, b);
  auto rr = __builtin_amdgcn_permlane32_swap(__float_as_uint(m), __float_as_uint(m), false, false);
  return max2f(__uint_as_float(rr[0]), __uint_as_float(rr[1]));
}
__device__ __forceinline__ void pv(f32x16* o, int vb, bf16x8 pa0, bf16x8 pa1, bf16x8 pa2, bf16x8 pa3) {
#pragma unroll
  for (int d0 = 0; d0 < 2; ++d0) { s16x4 lo[4], hi[4];
#pragma unroll
    for (int ks = 0; ks < 4; ++ks) {
      asm volatile("ds_read_b64_tr_b16 %0,%1 offset:%c2" : "=&v"(lo[ks]) : "v"(vb), "i"(d0 * 4096 + ks * 1024) : "memory");
      asm volatile("ds_read_b64_tr_b16 %0,%1 offset:%c2" : "=&v"(hi[ks]) : "v"(vb), "i"(d0 * 4096 + ks * 1024 + 512) : "memory"); }
    asm volatile("s_waitcnt lgkmcnt(0)" ::: "memory"); SBAR();
#define PK(k) (bf16x8){lo[k][0], lo[k][1], lo[k][2], lo[k][3], hi[k][0], hi[k][1], hi[k][2], hi[k][3]}
    o[d0] = __builtin_amdgcn_mfma_f32_32x32x16_bf16(pa0, PK(0), o[d0], 0, 0, 0);
    o[d0] = __builtin_amdgcn_mfma_f32_32x32x16_bf16(pa1, PK(1), o[d0], 0, 0, 0);
    o[d0] = __builtin_amdgcn_mfma_f32_32x32x16_bf16(pa2, PK(2), o[d0], 0, 0, 0);
    o[d0] = __builtin_amdgcn_mfma_f32_32x32x16_bf16(pa3, PK(3), o[d0], 0, 0, 0);
#undef PK
  }
}
template <int MODE>
__device__ __forceinline__ void modify(f32x16& P0, f32x16& P1, int gt, int cw, int wid, int r32, int hi, const LAS float* bias, float mref) {
  const float NEG = -INFINITY;
  if (MODE == 0) {
    if (gt >= cw) { asm volatile("; diagonal / above-diagonal tile" ::: "memory");
      const int qin = gt > cw ? -1 : 32 * (wid & 1) + r32 - 4 * hi;
#pragma unroll
      for (int r = 0; r < 16; ++r) { const int kin = (r & 3) + 8 * (r >> 2); if (kin > qin) P0[r] = NEG; if (kin + 32 > qin) P1[r] = NEG; } }
  }
  if (MODE == 2) {
    const int dj = cw - gt;
    if (dj < 0 || dj > 8) {
#pragma unroll
      for (int r = 0; r < 16; ++r) { P0[r] = NEG; P1[r] = NEG; }
    } else if (dj <= 2) { const int qoff = 64 * dj + 32 * (wid & 1) + r32 + 128;
#pragma unroll
      for (int r = 0; r < 16; ++r) { int i0 = qoff - crow(r, hi), i1 = i0 - 32; i0 = i0 > 256 ? 256 : i0; i1 = i1 > 256 ? 256 : i1; P0[r] += bias[i0]; P1[r] += bias[i1]; } }
  }
}
__device__ __forceinline__ void bias_preload(f32x16& C0, f32x16& C1, const LAS float* bias, int gt, int hi) {
  const LAS float* fb = bias + 64 * gt + 4 * hi;
#pragma unroll
  for (int g = 0; g < 4; ++g) { const f32x4 a = *(const LAS f32x4*)(fb + 8 * g), b = *(const LAS f32x4*)(fb + 32 + 8 * g);
#pragma unroll
    for (int i = 0; i < 4; ++i) { C0[4 * g + i] = a[i]; C1[4 * g + i] = b[i]; } }
}
__device__ __forceinline__ void mask_preload(f32x16& C0, f32x16& C1, const LAS char* mw, bool above, float mref, int r32, int hi) {
  const u32x2 w = *(const LAS u32x2*)(mw + 8 * r32); const int w0 = above ? 0 : (int)(w.x >> (4 * hi)), w1 = above ? 0 : (int)(w.y >> (4 * hi));
  const unsigned nm = __float_as_uint(-mref);
#pragma unroll
  for (int r = 0; r < 16; ++r) { const int cp = (r & 3) + 8 * (r >> 2); const unsigned m0 = (unsigned)__builtin_amdgcn_sbfe(w0, cp, 1), m1 = (unsigned)__builtin_amdgcn_sbfe(w1, cp, 1);
    C0[r] = __uint_as_float((nm & m0) | (0xFF800000u & ~m0)); C1[r] = __uint_as_float((nm & m1) | (0xFF800000u & ~m1)); }
}
__device__ __forceinline__ bf16x8 ref_frag(float m, int hi) {
  const unsigned h0 = f2bf(m); const float r1 = m - bf2f(h0); const unsigned h1 = f2bf(r1); const float r2 = r1 - bf2f(h1); const unsigned h2 = f2bf(r2);
  u32x4 w = {hi ? 0u : (h0 | (h1 << 16)), hi ? 0u : h2, 0u, 0u};
  return __builtin_bit_cast(bf16x8, w);
}
template <int MODE, int THRL>
__device__ __forceinline__ void attn_unit(const Prm& P, char* shm, int b, int hc, int qb, bf16x8 (&qpre)[4], f32x4& cpre0, f32x4& cpre1, f32x4& cpre2, f32x4& cpre3, bool fetched = false, int pf_mode = 0, int pf_a = -1, LAS int* pf_slot = nullptr, const LAS float* kmax_tab = nullptr) {
  const int tid = threadIdx.x, lane = tid & 63, r32 = lane & 31, hi = lane >> 5; const int wid = __builtin_amdgcn_readfirstlane(tid >> 6);
  bf16* Q = (bf16*)(P.ws + WS_QQ); const bf16* K = (const bf16*)(P.ws + WS_KK); const bf16* V = (const bf16*)(P.ws + WS_VV); const bf16* GG = (const bf16*)(P.ws + WS_GG);
  const long rowbase = (long)b * SEQ; const int q0 = qb * QB;
  const int T0 = MODE == 2 ? (4 * qb - 8 > 0 ? 4 * qb - 8 : 0) : 0;
  int NT = 4 * qb + 4 - T0;
  const int TTOP = 4 * qb + 3;
  const int cw = 4 * qb + (wid >> 1);
#define TL(t) (MODE == 2 ? (t) : (TTOP - (t)))
  const bf16* Qw = Q + (rowbase + q0 + wid * QBLK) * DMP + hc * 64;
  const bf16* Kh = K + (rowbase + T0 * KVBLK) * DMP + hc * 64, *Vh = V + (rowbase + T0 * KVBLK) * DMP + hc * 64;
  const unsigned lds0 = (unsigned)(uintptr_t)shm;
  float* wsf = (float*)(shm + LDS_WS) + wid * 64;
  const LAS float* bias = (const LAS float*)((LAS char*)(uintptr_t)lds0 + LDS_BIAS);
  { LAS float* bw = (LAS float*)((LAS char*)(uintptr_t)lds0 + LDS_BIAS);
    if (MODE == 0 && !fetched) { const float* FL = (const float*)(P.ws + WS_FL) + ((size_t)b * 8 + hc) * SEQ; for (int i = tid; i < q0 + QB; i += NTHR) bw[i] = FL[i]; }
    if (MODE == 2) { const float far = P.rel[hc * 257 + 256]; const int tq = opaque_tid(); if (tq < 257) bw[tq] = (P.rel[hc * 257 + tq] - far) * LOG2E; } }
  const bf16* ksrc = Kh + (long)lane * DMP + wid * 8;
  const bf16* vsrc = Vh + (long)(16 * (wid & 3) + (lane >> 2)) * DMP + (wid >> 2) * 32 + (lane & 3) * 8;
  const unsigned kdst = lds0 + LDS_K + wid * 1024, vdst = lds0 + LDS_V + wid * 1024;
#define DMA_K(t, slot) glds16(ksrc + (long)TL(t) * KVBLK * DMP, (unsigned)__builtin_amdgcn_readfirstlane(kdst + (slot)))
#define DMA_V(t, slot) glds16(vsrc + (long)TL(t) * KVBLK * DMP, (unsigned)__builtin_amdgcn_readfirstlane(vdst + (slot)))
  const int vb0 = (int)(lds0 + LDS_V) + ((lane >> 4) & 1) * 32 + (lane & 3) * 8 + (4 * hi + ((lane & 15) >> 2)) * 64;
  const char* Kbase = shm + LDS_K; bf16x8 kf[8];
  const lds_cptr shm3 = (lds_cptr)(uintptr_t)lds0; const lds_cptr kp0 = shm3 + LDS_K + hi * 1024 + r32 * 16; const lds_cptr vp0 = shm3 + LDS_V + ((lane >> 4) & 1) * 32 + (lane & 3) * 8 + (4 * hi + ((lane & 15) >> 2)) * 64;
  const unsigned* msrc = (const unsigned*)(P.ws + WS_MASK) + (size_t)(rowbase + q0 + wid * QBLK + (lane >> 1)) * 128 + (lane & 1);
  const unsigned mdst = lds0 + LDS_BIAS + wid * 768;
  const LAS char* mrd = (const LAS char*)(uintptr_t)mdst;
  int ms0 = 0, ms1 = 256, ms2 = 512;
#define DMA_M(t, slot) glds4(msrc + 2 * (T0 + TL(t)), (unsigned)__builtin_amdgcn_readfirstlane(mdst + (slot)))
#define MROT() do { const int m_ = ms0; ms0 = ms1; ms1 = ms2; ms2 = m_; } while (0)
  if (!fetched) {
    if (MODE == 1) { DMA_M(0, 0); }
    DMA_K(0, 0); DMA_V(0, 0); DMA_K(1, SLOTB);
    if (MODE == 1) { DMA_M(1, 256); } }
  bf16x8 qr[4];
  if (fetched) {
#pragma unroll
    for (int d0 = 0; d0 < 4; ++d0) qr[d0] = qpre[d0]; }
  else { int l2 = lane; asm volatile("" : "+v"(l2)); const unsigned qo = (unsigned)((l2 & 31) * DMP + (l2 >> 5) * 8) * 2u;
#pragma unroll
    for (int d0 = 0; d0 < 4; ++d0) qr[d0] = *reinterpret_cast<const bf16x8*>((const char*)Qw + qo + d0 * 32); }
  if (MODE == 1) {
    f32x4 c0, c1, s0, s1;
    if (fetched) { c0 = cpre0; c1 = cpre1; s0 = cpre2; s1 = cpre3; }
    else { int l2 = lane; asm volatile("" : "+v"(l2)); const size_t ro = (size_t)(rowbase + q0 + wid * QBLK + (l2 & 31)) * 8;
      const float* cp = (const float*)(P.ws + WS_COS) + ro; const float* sp = (const float*)(P.ws + WS_SIN) + ro;
      c0 = *(const f32x4*)cp; c1 = *(const f32x4*)(cp + 4); s0 = *(const f32x4*)sp; s1 = *(const f32x4*)(sp + 4); }
    cpre0 = f32x4{}; cpre1 = f32x4{}; cpre2 = f32x4{}; cpre3 = f32x4{};
    u32x4 own = __builtin_bit_cast(u32x4, qr[0]), oth;
#pragma unroll
    for (int i = 0; i < 4; ++i) oth[i] = __shfl_xor(own[i], 32);
    const float sg = hi ? 1.f : -1.f;
    u32x4 res;
#pragma unroll
    for (int i = 0; i < 4; ++i) { const float cA = i < 2 ? c0[2 * i] : c1[2 * i - 4], cB = i < 2 ? c0[2 * i + 1] : c1[2 * i - 3], sA = i < 2 ? s0[2 * i] : s1[2 * i - 4], sB = i < 2 ? s0[2 * i + 1] : s1[2 * i - 3];
      const float a = bf2f(own[i] & 0xFFFFu) * cA + sg * bf2f(oth[i] & 0xFFFFu) * sA, b = bf2f(own[i] >> 16) * cB + sg * bf2f(oth[i] >> 16) * sB; res[i] = pk2(a, b); }
    qr[0] = __builtin_bit_cast(bf16x8, res);
  }
  if (MODE == 0) { float q2 = 0.f;
#pragma unroll
    for (int d0 = 0; d0 < 4; ++d0) { const u32x4 w = __builtin_bit_cast(u32x4, qr[d0]);
#pragma unroll
      for (int i = 0; i < 4; ++i) { const float x0 = bf2f(w[i] & 0xFFFFu), x1 = bf2f(w[i] >> 16); q2 += x0 * x0 + x1 * x1; } }
    q2 += __shfl_xor(q2, 32);
#pragma unroll
    for (int o = 1; o < 32; o <<= 1) q2 = fmaxf(q2, __shfl_xor(q2, o));
    if (lane == 0) ((LAS float*)((LAS char*)(uintptr_t)lds0 + LDS_VOTE))[wid] = q2; }
  LAS bf16x8* qst = (LAS bf16x8*)((LAS char*)(uintptr_t)lds0 + LDS_OST + wid * 4096) + lane;
#pragma unroll
  for (int d0 = 0; d0 < 4; ++d0) qst[d0 * 64] = qr[d0];
#define QLD(d0) (qst[(d0) * 64])
  float mhat = 0.f, l_reg = 0.f; f32x16 o[2]; o[0] = f32x16{}; o[1] = f32x16{}; f32x16 negm = f32x16{}; asm volatile("" : "+v"(negm));
  bf16x8 qx = ref_frag(0.f, hi); const bf16x8 kx = __builtin_bit_cast(bf16x8, (u32x4){hi ? 0u : 0xBF80BF80u, hi ? 0u : 0x0000BF80u, 0u, 0u});
#define CMASK(P0, P1, t) modify<MODE>(P0, P1, T0 + TL(t), cw, wid, r32, hi, bias, mhat)
  bool resc = false;
#define START(P0, P1) do { const float rm = rowmax(P0, P1); resc = false; \
    { const float dl = max2f(rm, FLOOR); mhat = fadd_s(mhat, dl); \
      _Pragma("unroll") for (int r = 0; r < 16; ++r) { P0[r] = fsub_s(P0[r], dl); P1[r] = fsub_s(P1[r], dl); } \
      if (MODE == 2) { _Pragma("unroll") for (int r = 0; r < 16; ++r) negm[r] = -mhat; asm volatile("" : "+v"(negm)); } \
      if (MODE == 0) qx = ref_frag(mhat, hi); } \
    _Pragma("unroll") for (int r = 0; r < 16; ++r) P0[r] = __builtin_amdgcn_exp2f(P0[r]); } while (0)
#define RESC() do { if (resc) { asm volatile("s_waitcnt lgkmcnt(0)" ::: "memory"); \
      _Pragma("unroll") for (int d_ = 0; d_ < 2; ++d_) _Pragma("unroll") for (int r = 0; r < 16; ++r) o[d_][r] *= wsf[crow(r, hi)]; } } while (0)
  f32x16 pA0, pA1, pB0, pB1;
  int sl_prev = 0, sl_cur = 0, sl_next = SLOTB;
#define ROT() do { sl_prev = sl_cur; sl_cur = sl_next; sl_next = (sl_next == (NSLOT - 1) * SLOTB) ? 0 : sl_next + SLOTB; } while (0)
  DMA_K(2, 2 * SLOTB);
  if (MODE == 1) { WAIT_BAR(4); } else { WAIT_BAR(3); }
  if (MODE == 0) { const LAS float* qm = (const LAS float*)((LAS char*)(uintptr_t)lds0 + LDS_VOTE);
    const f32x4 qa = *(const LAS f32x4*)qm, qb4 = *(const LAS f32x4*)(qm + 4);
    const float q2m = fmaxf(fmaxf(fmaxf(qa[0], qa[1]), fmaxf(qa[2], qa[3])), fmaxf(fmaxf(qb4[0], qb4[1]), fmaxf(qb4[2], qb4[3])));
    const float kmax2 = kmax_tab ? kmax_tab[hc] : __uint_as_float(__hip_atomic_load((const unsigned*)(P.ws + WS_CTL) + CW_KMAX + b * 8 + hc, __ATOMIC_RELAXED, __HIP_MEMORY_SCOPE_AGENT));
    const float D = 150.0f + (float)THRL + 2.0f * (sqrtf(q2m * kmax2) * 1.001f + 2.0f);
    const bool need = lane >= 4 * qb || !(bias[q0] - bias[64 * lane + 63] > D);
    const int gmin = (int)__builtin_ctzll(__ballot(need) | (1ull << 63));
    int nt = 4 * qb + 4 - gmin; nt += nt & 1; NT = nt < 4 ? 4 : nt; }
  if (MODE == 0) { bias_preload(pA0, pA1, bias, T0 + TL(0), hi); qkt<true>(pA0, pA1, Kbase, qr, negm, r32, hi); }
  else if (MODE == 1) { mask_preload(pA0, pA1, mrd + ms0, T0 + TL(0) > cw, mhat, r32, hi); qkt<true>(pA0, pA1, Kbase, qr, negm, r32, hi); }
  else qkt<false>(pA0, pA1, Kbase, qr, negm, r32, hi);
  asm volatile("s_nop 15\n\ts_nop 7" : "+v"(pA0), "+v"(pA1)); CMASK(pA0, pA1, 0);
  START(pA0, pA1);
  _Pragma("unroll") for (int r = 0; r < 16; ++r) pA1[r] = __builtin_amdgcn_exp2f(pA1[r]);
  WAIT_BAR(0);
  if (MODE == 1) { DMA_M(2, 512); MROT(); }
  DMA_K(3, 0); DMA_V(1, SLOTB);
  ROT();
  kload8(kf, kp0 + sl_cur);
  if (MODE == 1) { WAIT_BAR(3); } else { WAIT_BAR(2); }
  s16x4 vlo[8], vhi[8]; u32x4 pw0, pw1, pw2, pw3;
#define PKW(P, B) cvtpk_s(P[B], P[B + 1])
#define PAF(k) __builtin_bit_cast(bf16x8, pw##k)
#define VFR(i) (bf16x8){vlo[i][0], vlo[i][1], vlo[i][2], vlo[i][3], vhi[i][0], vhi[i][1], vhi[i][2], vhi[i][3]}
#define PIN(x) asm volatile("" : "+v"(x))
#define MX3(a, b, c) __builtin_fmaxf(__builtin_fmaxf((a), (b)), (c))
#define GAPA(MF, A0, A1, A2, A3, W0, W1, PW) do { MF; sacc += A0; sacc += A1; sacc += A2; sacc += A3; PIN(sacc); W0; W1; PIN(PW); SBAR(); } while (0)
#define EX(v) __builtin_amdgcn_exp2f(v)
#define GAPB(MF, X, B) do { MF; X[B] = EX(X[B]); X[B + 1] = EX(X[B + 1]); X[B + 2] = EX(X[B + 2]); X[B + 3] = EX(X[B + 3]); PIN(X); SBAR(); } while (0)
#define VRD(i) do { vlo[i] = vtr(vp_ + (((i) >> 2) * 4096 + ((i) & 3) * 1024)); vhi[i] = vtr(vp_ + (((i) >> 2) * 4096 + ((i) & 3) * 1024 + 512)); } while (0)
#define KRD(G, j) do { if (G) { kload2(kf, kp0 + sl_next, j); SBAR(); } } while (0)
#define STEP(C0, C1, P0, P1, t, GK, GV, GL, GM) do { SBAR(); \
    if (MODE == 0) { bias_preload(C0, C1, bias, T0 + TL(t), hi); SBAR(); \
      C0 = __builtin_amdgcn_mfma_f32_32x32x16_bf16(kx, qx, C0, 0, 0, 0); C1 = __builtin_amdgcn_mfma_f32_32x32x16_bf16(kx, qx, C1, 0, 0, 0); SBAR(); } \
    if (MODE == 1) { mask_preload(C0, C1, mrd + ms0, T0 + TL(t) > cw, mhat, r32, hi); SBAR(); } \
    const lds_cptr vp_ = vp0 + sl_prev; \
    VRD(0); bf16x8 q_ = QLD(0); SBAR(); float sacc = (P0[0] + P0[1]); \
    GAPA(C0 = __builtin_amdgcn_mfma_f32_32x32x16_bf16(kf[0], q_, MODE != 2 ? C0 : negm, 0, 0, 0), P0[2], P0[3], P0[4], P0[5],     pw0[0] = PKW(P0, 0), pw0[1] = PKW(P0, 2), pw0); \
    VRD(4); SBAR(); GAPA(C1 = __builtin_amdgcn_mfma_f32_32x32x16_bf16(kf[1], q_, MODE != 2 ? C1 : negm, 0, 0, 0), P0[6], P0[7], P0[8], P0[9],     pw0[2] = PKW(P0, 4), pw0[3] = PKW(P0, 6), pw0); \
    VRD(1); q_ = QLD(1); SBAR(); GAPA(C0 = __builtin_amdgcn_mfma_f32_32x32x16_bf16(kf[2], q_, C0, 0, 0, 0),   P0[10], P0[11], P0[12], P0[13], pw1[0] = PKW(P0, 8), pw1[1] = PKW(P0, 10), pw1); \
    VRD(5); SBAR(); GAPA(C1 = __builtin_amdgcn_mfma_f32_32x32x16_bf16(kf[3], q_, C1, 0, 0, 0),   P0[14], P0[15], P1[0], P1[1],   pw1[2] = PKW(P0, 12), pw1[3] = PKW(P0, 14), pw1); \
    VRD(2); q_ = QLD(2); SBAR(); GAPA(C0 = __builtin_amdgcn_mfma_f32_32x32x16_bf16(kf[4], q_, C0, 0, 0, 0),   P1[2], P1[3], P1[4], P1[5],     pw2[0] = PKW(P1, 0), pw2[1] = PKW(P1, 2), pw2); \
    VRD(6); SBAR(); GAPA(C1 = __builtin_amdgcn_mfma_f32_32x32x16_bf16(kf[5], q_, C1, 0, 0, 0),   P1[6], P1[7], P1[8], P1[9],     pw2[2] = PKW(P1, 4), pw2[3] = PKW(P1, 6), pw2); \
    VRD(3); q_ = QLD(3); SBAR(); GAPA(C0 = __builtin_amdgcn_mfma_f32_32x32x16_bf16(kf[6], q_, C0, 0, 0, 0),   P1[10], P1[11], P1[12], P1[13], pw3[0] = PKW(P1, 8), pw3[1] = PKW(P1, 10), pw3); \
    VRD(7); SBAR(); GAPA(C1 = __builtin_amdgcn_mfma_f32_32x32x16_bf16(kf[7], q_, C1, 0, 0, 0),   P1[14], P1[15], 0.f, 0.f,       pw3[2] = PKW(P1, 12), pw3[3] = PKW(P1, 14), pw3); \
    l_reg += sacc; \
    if (MODE == 1 && (GM)) { DMA_M((t) + 2, ms2); } if (GK) { DMA_K((t) + 3, sl_cur); } if (GV) { DMA_V((t) + 1, sl_next); } \
    CMASK(C0, C1, t); \
    { float a = MX3(C0[0], C0[1], C1[0]), b = MX3(C0[2], C0[3], C1[1]); a = MX3(a, C1[2], C1[3]); \
      _Pragma("unroll") for (int r = 4; r < 16; r += 4) { a = MX3(a, C0[r], C0[r + 1]); b = MX3(b, C0[r + 2], C0[r + 3]); a = MX3(a, C1[r], C1[r + 1]); b = MX3(b, C1[r + 2], C1[r + 3]); } \
      float rm = __builtin_fmaxf(a, b); { auto rr = __builtin_amdgcn_permlane32_swap(__float_as_uint(rm), __float_as_uint(rm), false, false); rm = __builtin_fmaxf(__uint_as_float(rr[0]), __uint_as_float(rr[1])); } \
      resc = false; \
      if (__builtin_expect(__any(rm > (float)THRL), 0)) { const float dl = __builtin_fmaxf(rm, 0.f); mhat += dl; \
        _Pragma("unroll") for (int r = 0; r < 16; ++r) { C0[r] -= dl; C1[r] -= dl; } \
        if (MODE == 2) { _Pragma("unroll") for (int r = 0; r < 16; ++r) negm[r] = -mhat; asm volatile("" : "+v"(negm)); } \
        if (MODE == 0) qx = ref_frag(mhat, hi); \
        const float f = __builtin_amdgcn_exp2f(-dl); l_reg *= f; if (hi == 0) wsf[r32] = f; resc = true; } } \
    SBAR(); \
    GAPB(o[0] = __builtin_amdgcn_mfma_f32_32x32x16_bf16(PAF(0), VFR(0), o[0], 0, 0, 0), C0, 0); \
    GAPB(o[1] = __builtin_amdgcn_mfma_f32_32x32x16_bf16(PAF(0), VFR(4), o[1], 0, 0, 0), C0, 4); \
    KRD(GL, 0); GAPB(o[0] = __builtin_amdgcn_mfma_f32_32x32x16_bf16(PAF(1), VFR(1), o[0], 0, 0, 0), C0, 8); \
    KRD(GL, 1); GAPB(o[1] = __builtin_amdgcn_mfma_f32_32x32x16_bf16(PAF(1), VFR(5), o[1], 0, 0, 0), C0, 12); \
    KRD(GL, 2); GAPB(o[0] = __builtin_amdgcn_mfma_f32_32x32x16_bf16(PAF(2), VFR(2), o[0], 0, 0, 0), C1, 0); \
    KRD(GL, 3); GAPB(o[1] = __builtin_amdgcn_mfma_f32_32x32x16_bf16(PAF(2), VFR(6), o[1], 0, 0, 0), C1, 4); \
    GAPB(o[0] = __builtin_amdgcn_mfma_f32_32x32x16_bf16(PAF(3), VFR(3), o[0], 0, 0, 0), C1, 8); \
    GAPB(o[1] = __builtin_amdgcn_mfma_f32_32x32x16_bf16(PAF(3), VFR(7), o[1], 0, 0, 0), C1, 12); \
    } while (0)
  int t = 1;
#define WAITS() do { if (MODE == 1) { WAIT_BAR(3); } else { WAIT_BAR(2); } } while (0)
  for (; t + 5 < NT; t += 2) {
    STEP(pB0, pB1, pA0, pA1, t, true, true, true, true);     WAITS(); RESC(); ROT(); MROT();
    STEP(pA0, pA1, pB0, pB1, t + 1, true, true, true, true); WAITS(); RESC(); ROT(); MROT();
  }
#define ENDW(tt) do { if ((tt) + 3 < NT) { WAITS(); } else if ((tt) + 2 < NT) { if (MODE == 1) { WAIT_BAR(2); } else { WAIT_BAR(1); } } else { WAIT_BAR(0); } } while (0)
  for (; t + 1 < NT; t += 2) {
    STEP(pB0, pB1, pA0, pA1, t, (t + 3 < NT), (t + 1 < NT), (t + 1 < NT), (t + 2 < NT));         ENDW(t);     RESC(); ROT(); MROT();
    STEP(pA0, pA1, pB0, pB1, t + 1, (t + 4 < NT), (t + 2 < NT), (t + 2 < NT), (t + 3 < NT));     ENDW(t + 1); RESC(); ROT(); MROT();
  }
  STEP(pB0, pB1, pA0, pA1, NT - 1, false, false, false, false); RESC();
  const bf16* Gw = GG + (rowbase + q0 + wid * QBLK) * DMP + hc * 64;
  u32x4 gq[4];
#pragma unroll
  for (int i = 0; i < 4; ++i) gq[i] = *(const u32x4*)(Gw + (long)(i * 8 + (lane >> 3)) * DMP + (lane & 7) * 8);
  { float sacc = pB0[0] + pB0[1]; _Pragma("unroll") for (int r = 2; r < 16; ++r) sacc += pB0[r]; _Pragma("unroll") for (int r = 0; r < 16; ++r) sacc += pB1[r]; l_reg += sacc;
    pw0 = (u32x4){PKW(pB0, 0), PKW(pB0, 2), PKW(pB0, 4), PKW(pB0, 6)}; pw1 = (u32x4){PKW(pB0, 8), PKW(pB0, 10), PKW(pB0, 12), PKW(pB0, 14)}; pw2 = (u32x4){PKW(pB1, 0), PKW(pB1, 2), PKW(pB1, 4), PKW(pB1, 6)}; pw3 = (u32x4){PKW(pB1, 8), PKW(pB1, 10), PKW(pB1, 12), PKW(pB1, 14)};
    SBAR(); pv(o, vb0 + sl_cur, PAF(0), PAF(1), PAF(2), PAF(3)); }
  if (MODE != 2 && pf_mode != 0) {
    if (pf_mode == 2 && tid == 0) *pf_slot = pf_a;
    asm volatile("s_waitcnt lgkmcnt(0)\n\ts_barrier" ::: "memory");
    int nhc = hc, nqb = pf_a;
    if (pf_mode == 2) { const int nx = __builtin_amdgcn_readfirstlane(*pf_slot); nhc = nx & 7; nqb = nx < 128 ? 15 - (nx >> 3) : -1; }
    if (nqb >= 0) {
      const int ntop = 4 * nqb + 3;
      const bf16* kn = K + rowbase * DMP + nhc * 64 + (long)ntop * KVBLK * DMP; const bf16* vn = V + rowbase * DMP + nhc * 64 + (long)ntop * KVBLK * DMP;
      const unsigned* mn = (const unsigned*)(P.ws + WS_MASK) + (size_t)(rowbase + nqb * QB + wid * QBLK) * 128 + 2 * ntop;
      const unsigned ko = (unsigned)(lane * DMP + wid * 8) * 2u, vo = (unsigned)((16 * (wid & 3) + (lane >> 2)) * DMP + (wid >> 2) * 32 + (lane & 3) * 8) * 2u, mo = (unsigned)((lane >> 1) * 128 + (lane & 1)) * 4u;
      if (MODE == 1) glds4s(mn, mo, (unsigned)__builtin_amdgcn_readfirstlane(mdst));
      glds16s(kn, ko, (unsigned)__builtin_amdgcn_readfirstlane(kdst)); glds16s(vn, vo, (unsigned)__builtin_amdgcn_readfirstlane(vdst)); glds16s(kn - (long)KVBLK * DMP, ko, (unsigned)__builtin_amdgcn_readfirstlane(kdst + SLOTB));
      if (MODE == 1) glds4s(mn - 2, mo, (unsigned)__builtin_amdgcn_readfirstlane(mdst + 256));
      { const char* Qn = (const char*)(Q + (rowbase + nqb * QB + wid * QBLK) * DMP + nhc * 64);
        int l2 = lane; asm volatile("" : "+v"(l2));
        const unsigned qo = (unsigned)((l2 & 31) * DMP + (l2 >> 5) * 8) * 2u;
#pragma unroll
        for (int d0 = 0; d0 < 4; ++d0) qpre[d0] = *reinterpret_cast<const bf16x8*>(Qn + qo + d0 * 32); }
      if (MODE == 1) { int l3 = lane; asm volatile("" : "+v"(l3)); const size_t ro = (size_t)(rowbase + nqb * QB + wid * QBLK + (l3 & 31)) * 8;
        const float* cp = (const float*)(P.ws + WS_COS) + ro; const float* sp = (const float*)(P.ws + WS_SIN) + ro;
        cpre0 = *(const f32x4*)cp; cpre1 = *(const f32x4*)(cp + 4); cpre2 = *(const f32x4*)sp; cpre3 = *(const f32x4*)(sp + 4); }
      if (MODE == 0) { const unsigned* fn = (const unsigned*)(P.ws + WS_FL) + ((size_t)b * 8 + nhc) * SEQ;
        const unsigned fo = (unsigned)lane * 4u; const int lim = 4 * (nqb + 1);
#pragma unroll
        for (int k = 0; k < 8; ++k) { const int c = wid + NW * k; if (c < lim) glds4s(fn + 64 * c, fo, (unsigned)__builtin_amdgcn_readfirstlane(lds0 + LDS_BIAS + 256 * c)); } } } }
#undef PKW
#undef PAF
#undef VFR
#undef PIN
#undef MX3
#undef GAPA
#undef GAPB
#undef EX
#undef VRD
#undef KRD
#undef STEP
#undef ENDW
#undef WAITS
  { auto rr = __builtin_amdgcn_permlane32_swap(__float_as_uint(l_reg), __float_as_uint(l_reg), false, false); l_reg = __uint_as_float(rr[0]) + __uint_as_float(rr[1]); }
  if (hi == 0) wsf[32 + r32] = l_reg; asm volatile("s_waitcnt lgkmcnt(0)" ::: "memory");
  float rli[16];
#pragma unroll
  for (int r = 0; r < 16; ++r) rli[r] = __builtin_amdgcn_rcpf(wsf[32 + crow(r, hi)]);
#if defined(REP_PHASE)
  int oalt_ = P.o_alt; asm volatile("" : "+s"(oalt_));
  bf16* Ow = (oalt_ ? (bf16*)(P.ws + WS_Y) : Q) + (rowbase + q0 + wid * QBLK) * DMP + hc * 64;
#else
  bf16* Ow = Q + (rowbase + q0 + wid * QBLK) * DMP + hc * 64;
#endif
  { bf16* stg = (bf16*)(shm + LDS_OST) + wid * 2048;
#pragma unroll
    for (int r = 0; r < 16; ++r) { const int orow = crow(r, hi);
#pragma unroll
      for (int d0 = 0; d0 < 2; ++d0) stg[orow * 64 + d0 * 32 + r32] = (bf16)f2bf(o[d0][r] * rli[r]); }
    asm volatile("s_waitcnt lgkmcnt(0)" ::: "memory");
#pragma unroll
    for (int i = 0; i < 4; ++i) { const int row = i * 8 + (lane >> 3), ch = lane & 7; const u32x4 v = *(const u32x4*)(stg + row * 64 + ch * 8);
      u32x4 w;
#pragma unroll
      for (int k = 0; k < 4; ++k) { const float g0 = bf2f(gq[i][k] & 0xFFFFu), g1 = bf2f(gq[i][k] >> 16);
        const float a0 = bf2f(v[k] & 0xFFFFu) * g0 * __builtin_amdgcn_rcpf(1.f + __expf(-g0)), a1 = bf2f(v[k] >> 16) * g1 * __builtin_amdgcn_rcpf(1.f + __expf(-g1)); w[k] = pk2(a0, a1); }
      *(u32x4*)(Ow + (long)row * DMP + ch * 8) = w; } }
  asm volatile("s_waitcnt vmcnt(0) lgkmcnt(0)\n\ts_barrier" ::: "memory");
#undef DMA_K
#undef DMA_V
#undef DMA_M
#undef MROT
#undef CMASK
#undef START
#undef RESC
#undef ROT
#undef TL
#undef QLD
}
__device__ __forceinline__ void band_modify(f32x16& P0, f32x16& P1, bool valid, int step, int wid, int r32, int hi, const LAS float* bias) {
  const float NEG = -INFINITY;
  if (!valid) {
#pragma unroll
    for (int r = 0; r < 16; ++r) { P0[r] = NEG; P1[r] = NEG; }
  } else if (step >= 6) { const int qoff = 64 * (8 - step) + 32 * (wid & 1) + r32 + 128;
#pragma unroll
    for (int r = 0; r < 16; ++r) { int i0 = qoff - crow(r, hi), i1 = i0 - 32; i0 = i0 > 256 ? 256 : i0; i1 = i1 > 256 ? 256 : i1; P0[r] += bias[i0]; P1[r] += bias[i1]; } }
}
__device__ __forceinline__ void attn_band_unit(const Prm& P, char* shm, int b, int hc, int qb, bf16x8 (&qpre)[4], bool fetched, bool fetch_next) {
  constexpr int MODE = 2, THRL = 8;
  constexpr int B_NS = 6, B_K = 0, B_V = B_NS * SLOTB, B_WS = 2 * B_NS * SLOTB, B_OST = B_WS + NW * 64 * 4, B_END = B_OST + NW * 4096, B_BIAS = B_END;
  static_assert(B_BIAS + 2048 <= MISC_OFF, "band attention LDS map");
  const int tid = threadIdx.x, lane = tid & 63, r32 = lane & 31, hi = lane >> 5; const int wid = __builtin_amdgcn_readfirstlane(tid >> 6);
  bf16* Q = (bf16*)(P.ws + WS_QQ); const bf16* K = (const bf16*)(P.ws + WS_KK); const bf16* V = (const bf16*)(P.ws + WS_VV); const bf16* GG = (const bf16*)(P.ws + WS_GG);
  const long rowbase = (long)b * SEQ; const int q0 = qb * QB;
  const int g0 = 4 * qb - 8, jp = wid >> 1;
  const int T0 = 0, cw = 4 * qb + jp; int NT = 12; const int TTOP = 0; (void)NT; (void)TTOP; (void)cw;
#define TL(t) (g0 + (t) > 0 ? g0 + (t) : 0)
#define SLOT(n) ((((n) + 6) % 6) * SLOTB)
#define SLW(c) (((((c) + 6) % 6) + jp >= 6 ? (((c) + 6) % 6) + jp - 6 : (((c) + 6) % 6) + jp) * SLOTB)
  const bf16* Qw = Q + (rowbase + q0 + wid * QBLK) * DMP + hc * 64;
  const bf16* Kh = K + (rowbase + T0 * KVBLK) * DMP + hc * 64, *Vh = V + (rowbase + T0 * KVBLK) * DMP + hc * 64;
  const unsigned lds0 = (unsigned)(uintptr_t)shm;
  float* wsf = (float*)(shm + B_WS) + wid * 64;
  const LAS float* bias = (const LAS float*)((LAS char*)(uintptr_t)lds0 + B_BIAS);
  { LAS float* bw = (LAS float*)((LAS char*)(uintptr_t)lds0 + B_BIAS);
    if (MODE == 0) { const float* FL = (const float*)(P.ws + WS_FL) + ((size_t)b * 8 + hc) * SEQ; for (int i = tid; i < q0 + QB; i += NTHR) bw[i] = FL[i]; }
    if (MODE == 2 && !fetched) { const float far = P.rel[hc * 257 + 256]; const int tq = opaque_tid(); if (tq < 257) bw[tq] = (P.rel[hc * 257 + tq] - far) * LOG2E; } }
  const bf16* ksrc = Kh + (long)lane * DMP + wid * 8;
  const bf16* vsrc = Vh + (long)(16 * (wid & 3) + (lane >> 2)) * DMP + (wid >> 2) * 32 + (lane & 3) * 8;
  const unsigned kdst = lds0 + B_K + wid * 1024, vdst = lds0 + B_V + wid * 1024;
#define DMA_K(t, slot) glds16(ksrc + (long)TL(t) * KVBLK * DMP, (unsigned)__builtin_amdgcn_readfirstlane(kdst + (slot)))
#define DMA_V(t, slot) glds16(vsrc + (long)TL(t) * KVBLK * DMP, (unsigned)__builtin_amdgcn_readfirstlane(vdst + (slot)))
  const int vb0 = (int)(lds0 + B_V) + ((lane >> 4) & 1) * 32 + (lane & 3) * 8 + (4 * hi + ((lane & 15) >> 2)) * 64;
  const char* Kbase = shm + B_K; bf16x8 kf[8];
  const lds_cptr shm3 = (lds_cptr)(uintptr_t)lds0; const lds_cptr kp0 = shm3 + B_K + hi * 1024 + r32 * 16; const lds_cptr vp0 = shm3 + B_V + ((lane >> 4) & 1) * 32 + (lane & 3) * 8 + (4 * hi + ((lane & 15) >> 2)) * 64;
  const unsigned* msrc = (const unsigned*)(P.ws + WS_MASK) + (size_t)(rowbase + q0 + wid * QBLK + (lane >> 1)) * 128 + (lane & 1);
  const unsigned mdst = lds0 + B_BIAS + wid * 768;
  const LAS char* mrd = (const LAS char*)(uintptr_t)mdst;
  int ms0 = 0, ms1 = 256, ms2 = 512;
#define DMA_M(t, slot) glds4(msrc + 2 * (T0 + TL(t)), (unsigned)__builtin_amdgcn_readfirstlane(mdst + (slot)))
#define MROT() do { const int m_ = ms0; ms0 = ms1; ms1 = ms2; ms2 = m_; } while (0)
  if (!fetched) { DMA_K(0, SLOT(0)); DMA_V(0, SLOT(0)); DMA_K(1, SLOT(1)); DMA_V(1, SLOT(1)); DMA_K(2, SLOT(2)); DMA_V(2, SLOT(2)); DMA_K(3, SLOT(3)); DMA_V(3, SLOT(3)); DMA_K(4, SLOT(4)); DMA_K(5, SLOT(5)); }
  bf16x8 qr[4];
  if (fetched) {
#pragma unroll
    for (int d0 = 0; d0 < 4; ++d0) qr[d0] = qpre[d0]; }
  else { int l2 = lane; asm volatile("" : "+v"(l2)); const unsigned qo = (unsigned)((l2 & 31) * DMP + (l2 >> 5) * 8) * 2u;
#pragma unroll
    for (int d0 = 0; d0 < 4; ++d0) qr[d0] = *reinterpret_cast<const bf16x8*>((const char*)Qw + qo + d0 * 32); }
  if (MODE == 1) {
    const float* cp = (const float*)(P.ws + WS_COS) + (size_t)(rowbase + q0 + wid * QBLK + r32) * 8; const float* sp = (const float*)(P.ws + WS_SIN) + (size_t)(rowbase + q0 + wid * QBLK + r32) * 8;
    const f32x4 c0 = *(const f32x4*)cp, c1 = *(const f32x4*)(cp + 4), s0 = *(const f32x4*)sp, s1 = *(const f32x4*)(sp + 4);
    u32x4 own = __builtin_bit_cast(u32x4, qr[0]), oth;
#pragma unroll
    for (int i = 0; i < 4; ++i) oth[i] = __shfl_xor(own[i], 32);
    const float sg = hi ? 1.f : -1.f;
    u32x4 res;
#pragma unroll
    for (int i = 0; i < 4; ++i) { const float cA = i < 2 ? c0[2 * i] : c1[2 * i - 4], cB = i < 2 ? c0[2 * i + 1] : c1[2 * i - 3], sA = i < 2 ? s0[2 * i] : s1[2 * i - 4], sB = i < 2 ? s0[2 * i + 1] : s1[2 * i - 3];
      const float a = bf2f(own[i] & 0xFFFFu) * cA + sg * bf2f(oth[i] & 0xFFFFu) * sA, b = bf2f(own[i] >> 16) * cB + sg * bf2f(oth[i] >> 16) * sB; res[i] = pk2(a, b); }
    qr[0] = __builtin_bit_cast(bf16x8, res);
  }
  if (MODE == 0) { float q2 = 0.f;
#pragma unroll
    for (int d0 = 0; d0 < 4; ++d0) { const u32x4 w = __builtin_bit_cast(u32x4, qr[d0]);
#pragma unroll
      for (int i = 0; i < 4; ++i) { const float x0 = bf2f(w[i] & 0xFFFFu), x1 = bf2f(w[i] >> 16); q2 += x0 * x0 + x1 * x1; } }
    q2 += __shfl_xor(q2, 32);
#pragma unroll
    for (int o = 1; o < 32; o <<= 1) q2 = fmaxf(q2, __shfl_xor(q2, o));
    if (lane == 0) ((LAS float*)((LAS char*)(uintptr_t)lds0 + LDS_VOTE))[wid] = q2; }
  LAS bf16x8* qst = (LAS bf16x8*)((LAS char*)(uintptr_t)lds0 + B_OST + wid * 4096) + lane;
#pragma unroll
  for (int d0 = 0; d0 < 4; ++d0) qst[d0 * 64] = qr[d0];
#define QLD(d0) (qst[(d0) * 64])
  float mhat = 0.f, l_reg = 0.f; f32x16 o[2]; o[0] = f32x16{}; o[1] = f32x16{}; f32x16 negm = f32x16{}; asm volatile("" : "+v"(negm));
#define CMASK(P0, P1, t) band_modify(P0, P1, g0 + (t) + jp >= 0, (t), wid, r32, hi, bias)
  bool resc = false;
#define START(P0, P1) do { const float rm = rowmax(P0, P1); resc = false; \
    { const float dl = max2f(rm, FLOOR); mhat = fadd_s(mhat, dl); \
      _Pragma("unroll") for (int r = 0; r < 16; ++r) { P0[r] = fsub_s(P0[r], dl); P1[r] = fsub_s(P1[r], dl); } \
      if (MODE == 2) { _Pragma("unroll") for (int r = 0; r < 16; ++r) negm[r] = -mhat; asm volatile("" : "+v"(negm)); } } \
    _Pragma("unroll") for (int r = 0; r < 16; ++r) P0[r] = __builtin_amdgcn_exp2f(P0[r]); } while (0)
#define RESC() do { if (resc) { asm volatile("s_waitcnt lgkmcnt(0)" ::: "memory"); \
      _Pragma("unroll") for (int d_ = 0; d_ < 2; ++d_) _Pragma("unroll") for (int r = 0; r < 16; ++r) o[d_][r] *= wsf[crow(r, hi)]; } } while (0)
  f32x16 pA0, pA1, pB0, pB1;
#define ROT() do { sl_prev = sl_cur; sl_cur = sl_next; sl_next = (sl_next == (B_NS - 1) * SLOTB) ? 0 : sl_next + SLOTB; } while (0)
  WAIT_BAR(0);
  if (MODE == 0) { const LAS float* qm = (const LAS float*)((LAS char*)(uintptr_t)lds0 + LDS_VOTE);
    const f32x4 qa = *(const LAS f32x4*)qm, qb4 = *(const LAS f32x4*)(qm + 4);
    const float q2m = fmaxf(fmaxf(fmaxf(qa[0], qa[1]), fmaxf(qa[2], qa[3])), fmaxf(fmaxf(qb4[0], qb4[1]), fmaxf(qb4[2], qb4[3])));
    const float kmax2 = __uint_as_float(__hip_atomic_load((const unsigned*)(P.ws + WS_CTL) + CW_KMAX + b * 8 + hc, __ATOMIC_RELAXED, __HIP_MEMORY_SCOPE_AGENT));
    const float D = 150.0f + (float)THRL + 2.0f * (sqrtf(q2m * kmax2) * 1.001f + 2.0f);
    const bool need = lane >= 4 * qb || !(bias[q0] - bias[64 * lane + 63] > D);
    const int gmin = (int)__builtin_ctzll(__ballot(need) | (1ull << 63));
    int nt = 4 * qb + 4 - gmin; nt += nt & 1; NT = nt < 4 ? 4 : nt; }
  if (MODE == 0) { bias_preload(pA0, pA1, bias, T0 + TL(0), hi); qkt<true>(pA0, pA1, Kbase, qr, negm, r32, hi); }
  else if (MODE == 1) { mask_preload(pA0, pA1, mrd + ms0, T0 + TL(0) > cw, mhat, r32, hi); qkt<true>(pA0, pA1, Kbase, qr, negm, r32, hi); }
  else qkt<false>(pA0, pA1, Kbase + SLW(0), qr, negm, r32, hi);
  asm volatile("s_nop 15\n\ts_nop 7" : "+v"(pA0), "+v"(pA1)); CMASK(pA0, pA1, 0);
  START(pA0, pA1);
  _Pragma("unroll") for (int r = 0; r < 16; ++r) pA1[r] = __builtin_amdgcn_exp2f(pA1[r]);
  WAIT_BAR(0);
  DMA_K(6, SLOT(0)); DMA_V(4, SLOT(4));
  kload8(kf, kp0 + SLW(1));
  WAIT_BAR(2);
  s16x4 vlo[8], vhi[8]; u32x4 pw0, pw1, pw2, pw3;
#define PKW(P, B) cvtpk_s(P[B], P[B + 1])
#define PAF(k) __builtin_bit_cast(bf16x8, pw##k)
#define VFR(i) (bf16x8){vlo[i][0], vlo[i][1], vlo[i][2], vlo[i][3], vhi[i][0], vhi[i][1], vhi[i][2], vhi[i][3]}
#define PIN(x) asm volatile("" : "+v"(x))
#define MX3(a, b, c) __builtin_fmaxf(__builtin_fmaxf((a), (b)), (c))
#define GAPA(MF, A0, A1, A2, A3, W0, W1, PW) do { MF; sacc += A0; sacc += A1; sacc += A2; sacc += A3; PIN(sacc); W0; W1; PIN(PW); SBAR(); } while (0)
#define EX(v) __builtin_amdgcn_exp2f(v)
#define GAPB(MF, X, B) do { MF; X[B] = EX(X[B]); X[B + 1] = EX(X[B + 1]); X[B + 2] = EX(X[B + 2]); X[B + 3] = EX(X[B + 3]); PIN(X); SBAR(); } while (0)
#define VRD(i) do { vlo[i] = vtr(vp_ + (((i) >> 2) * 4096 + ((i) & 3) * 1024)); vhi[i] = vtr(vp_ + (((i) >> 2) * 4096 + ((i) & 3) * 1024 + 512)); } while (0)
#define KRD(G, j) do { if (G) { kload2(kf, kp0 + sl_next, j); SBAR(); } } while (0)
#define STEP(C0, C1, P0, P1, t, GK, GV, GL, GM) do { SBAR(); const int sl_next = SLW((t) + 1); \
    if (MODE == 0) { bias_preload(C0, C1, bias, T0 + TL(t), hi); SBAR(); } \
    if (MODE == 1) { mask_preload(C0, C1, mrd + ms0, T0 + TL(t) > cw, mhat, r32, hi); SBAR(); } \
    const lds_cptr vp_ = vp0 + SLW((t) - 1); \
    VRD(0); bf16x8 q_ = QLD(0); SBAR(); float sacc = (P0[0] + P0[1]); \
    GAPA(C0 = __builtin_amdgcn_mfma_f32_32x32x16_bf16(kf[0], q_, MODE != 2 ? C0 : negm, 0, 0, 0), P0[2], P0[3], P0[4], P0[5],     pw0[0] = PKW(P0, 0), pw0[1] = PKW(P0, 2), pw0); \
    VRD(4); SBAR(); GAPA(C1 = __builtin_amdgcn_mfma_f32_32x32x16_bf16(kf[1], q_, MODE != 2 ? C1 : negm, 0, 0, 0), P0[6], P0[7], P0[8], P0[9],     pw0[2] = PKW(P0, 4), pw0[3] = PKW(P0, 6), pw0); \
    VRD(1); q_ = QLD(1); SBAR(); GAPA(C0 = __builtin_amdgcn_mfma_f32_32x32x16_bf16(kf[2], q_, C0, 0, 0, 0),   P0[10], P0[11], P0[12], P0[13], pw1[0] = PKW(P0, 8), pw1[1] = PKW(P0, 10), pw1); \
    VRD(5); SBAR(); GAPA(C1 = __builtin_amdgcn_mfma_f32_32x32x16_bf16(kf[3], q_, C1, 0, 0, 0),   P0[14], P0[15], P1[0], P1[1],   pw1[2] = PKW(P0, 12), pw1[3] = PKW(P0, 14), pw1); \
    VRD(2); q_ = QLD(2); SBAR(); GAPA(C0 = __builtin_amdgcn_mfma_f32_32x32x16_bf16(kf[4], q_, C0, 0, 0, 0),   P1[2], P1[3], P1[4], P1[5],     pw2[0] = PKW(P1, 0), pw2[1] = PKW(P1, 2), pw2); \
    VRD(6); SBAR(); GAPA(C1 = __builtin_amdgcn_mfma_f32_32x32x16_bf16(kf[5], q_, C1, 0, 0, 0),   P1[6], P1[7], P1[8], P1[9],     pw2[2] = PKW(P1, 4), pw2[3] = PKW(P1, 6), pw2); \
    VRD(3); q_ = QLD(3); SBAR(); GAPA(C0 = __builtin_amdgcn_mfma_f32_32x32x16_bf16(kf[6], q_, C0, 0, 0, 0),   P1[10], P1[11], P1[12], P1[13], pw3[0] = PKW(P1, 8), pw3[1] = PKW(P1, 10), pw3); \
    VRD(7); SBAR(); GAPA(C1 = __builtin_amdgcn_mfma_f32_32x32x16_bf16(kf[7], q_, C1, 0, 0, 0),   P1[14], P1[15], 0.f, 0.f,       pw3[2] = PKW(P1, 12), pw3[3] = PKW(P1, 14), pw3); \
    l_reg += sacc; \
    if (GK) { DMA_K((t) + 6, SLOT(t)); } if (GV) { DMA_V((t) + 4, SLOT((t) + 4)); } \
    CMASK(C0, C1, t); \
    { float a = MX3(C0[0], C0[1], C1[0]), b = MX3(C0[2], C0[3], C1[1]); a = MX3(a, C1[2], C1[3]); \
      _Pragma("unroll") for (int r = 4; r < 16; r += 4) { a = MX3(a, C0[r], C0[r + 1]); b = MX3(b, C0[r + 2], C0[r + 3]); a = MX3(a, C1[r], C1[r + 1]); b = MX3(b, C1[r + 2], C1[r + 3]); } \
      float rm = __builtin_fmaxf(a, b); { auto rr = __builtin_amdgcn_permlane32_swap(__float_as_uint(rm), __float_as_uint(rm), false, false); rm = __builtin_fmaxf(__uint_as_float(rr[0]), __uint_as_float(rr[1])); } \
      resc = false; \
      if (__builtin_expect(__any(rm > (float)THRL), 0)) { const float dl = __builtin_fmaxf(rm, 0.f); mhat += dl; \
        _Pragma("unroll") for (int r = 0; r < 16; ++r) { C0[r] -= dl; C1[r] -= dl; } \
        if (MODE == 2) { _Pragma("unroll") for (int r = 0; r < 16; ++r) negm[r] = -mhat; asm volatile("" : "+v"(negm)); } \
        const float f = __builtin_amdgcn_exp2f(-dl); l_reg *= f; if (hi == 0) wsf[r32] = f; resc = true; } } \
    SBAR(); \
    GAPB(o[0] = __builtin_amdgcn_mfma_f32_32x32x16_bf16(PAF(0), VFR(0), o[0], 0, 0, 0), C0, 0); \
    GAPB(o[1] = __builtin_amdgcn_mfma_f32_32x32x16_bf16(PAF(0), VFR(4), o[1], 0, 0, 0), C0, 4); \
    KRD(GL, 0); GAPB(o[0] = __builtin_amdgcn_mfma_f32_32x32x16_bf16(PAF(1), VFR(1), o[0], 0, 0, 0), C0, 8); \
    KRD(GL, 1); GAPB(o[1] = __builtin_amdgcn_mfma_f32_32x32x16_bf16(PAF(1), VFR(5), o[1], 0, 0, 0), C0, 12); \
    KRD(GL, 2); GAPB(o[0] = __builtin_amdgcn_mfma_f32_32x32x16_bf16(PAF(2), VFR(2), o[0], 0, 0, 0), C1, 0); \
    KRD(GL, 3); GAPB(o[1] = __builtin_amdgcn_mfma_f32_32x32x16_bf16(PAF(2), VFR(6), o[1], 0, 0, 0), C1, 4); \
    GAPB(o[0] = __builtin_amdgcn_mfma_f32_32x32x16_bf16(PAF(3), VFR(3), o[0], 0, 0, 0), C1, 8); \
    GAPB(o[1] = __builtin_amdgcn_mfma_f32_32x32x16_bf16(PAF(3), VFR(7), o[1], 0, 0, 0), C1, 12); \
    } while (0)
  STEP(pB0, pB1, pA0, pA1, 1, true, true, true, false);  WAIT_BAR(2); RESC();
  STEP(pA0, pA1, pB0, pB1, 2, true, true, true, false);  WAIT_BAR(2); RESC();
  STEP(pB0, pB1, pA0, pA1, 3, true, true, true, false);  WAIT_BAR(2); RESC();
  STEP(pA0, pA1, pB0, pB1, 4, true, true, true, false);  WAIT_BAR(2); RESC();
  STEP(pB0, pB1, pA0, pA1, 5, true, true, true, false);  WAIT_BAR(2); RESC();
  STEP(pA0, pA1, pB0, pB1, 6, false, true, true, false); WAIT_BAR(1); RESC();
  STEP(pB0, pB1, pA0, pA1, 7, false, true, true, false); WAIT_BAR(0); RESC();
  STEP(pA0, pA1, pB0, pB1, 8, false, false, false, false); RESC();
  const bf16* Gw = GG + (rowbase + q0 + wid * QBLK) * DMP + hc * 64;
  u32x4 gq[4];
#pragma unroll
  for (int i = 0; i < 4; ++i) gq[i] = *(const u32x4*)(Gw + (long)(i * 8 + (lane >> 3)) * DMP + (lane & 7) * 8);
  { float sacc = pA0[0] + pA0[1]; _Pragma("unroll") for (int r = 2; r < 16; ++r) sacc += pA0[r]; _Pragma("unroll") for (int r = 0; r < 16; ++r) sacc += pA1[r]; l_reg += sacc;
    pw0 = (u32x4){PKW(pA0, 0), PKW(pA0, 2), PKW(pA0, 4), PKW(pA0, 6)}; pw1 = (u32x4){PKW(pA0, 8), PKW(pA0, 10), PKW(pA0, 12), PKW(pA0, 14)}; pw2 = (u32x4){PKW(pA1, 0), PKW(pA1, 2), PKW(pA1, 4), PKW(pA1, 6)}; pw3 = (u32x4){PKW(pA1, 8), PKW(pA1, 10), PKW(pA1, 12), PKW(pA1, 14)};
    SBAR(); pv(o, vb0 + SLW(8), PAF(0), PAF(1), PAF(2), PAF(3)); }
  if (fetch_next) {
    asm volatile("s_waitcnt lgkmcnt(0)\n\ts_barrier" ::: "memory");
#define TLN(n) (g0 + 4 + (n) > 0 ? g0 + 4 + (n) : 0)
#define DMA_KN(n) glds16(ksrc + (long)TLN(n) * KVBLK * DMP, (unsigned)__builtin_amdgcn_readfirstlane(kdst + SLOT(n)))
#define DMA_VN(n) glds16(vsrc + (long)TLN(n) * KVBLK * DMP, (unsigned)__builtin_amdgcn_readfirstlane(vdst + SLOT(n)))
    DMA_KN(0); DMA_VN(0); DMA_KN(1); DMA_VN(1); DMA_KN(2); DMA_VN(2); DMA_KN(3); DMA_VN(3); DMA_KN(4); DMA_KN(5);
#undef TLN
#undef DMA_KN
#undef DMA_VN
  }
#undef PKW
#undef PAF
#undef VFR
#undef PIN
#undef MX3
#undef GAPA
#undef GAPB
#undef EX
#undef VRD
#undef KRD
#undef STEP
#undef ENDW
#undef WAITS
  { auto rr = __builtin_amdgcn_permlane32_swap(__float_as_uint(l_reg), __float_as_uint(l_reg), false, false); l_reg = __uint_as_float(rr[0]) + __uint_as_float(rr[1]); }
  if (hi == 0) wsf[32 + r32] = l_reg; asm volatile("s_waitcnt lgkmcnt(0)" ::: "memory");
  float rli[16];
#pragma unroll
  for (int r = 0; r < 16; ++r) rli[r] = __builtin_amdgcn_rcpf(wsf[32 + crow(r, hi)]);
#if defined(REP_PHASE)
  int oalt_ = P.o_alt; asm volatile("" : "+s"(oalt_));
  bf16* Ow = (oalt_ ? (bf16*)(P.ws + WS_Y) : Q) + (rowbase + q0 + wid * QBLK) * DMP + hc * 64;
#else
  bf16* Ow = Q + (rowbase + q0 + wid * QBLK) * DMP + hc * 64;
#endif
  { bf16* stg = (bf16*)(shm + B_OST) + wid * 2048;
#pragma unroll
    for (int r = 0; r < 16; ++r) { const int orow = crow(r, hi);
#pragma unroll
      for (int d0 = 0; d0 < 2; ++d0) stg[orow * 64 + d0 * 32 + r32] = (bf16)f2bf(o[d0][r] * rli[r]); }
    asm volatile("s_waitcnt lgkmcnt(0)" ::: "memory");
#pragma unroll
    for (int i = 0; i < 4; ++i) { const int row = i * 8 + (lane >> 3), ch = lane & 7; const u32x4 v = *(const u32x4*)(stg + row * 64 + ch * 8);
      u32x4 w;
#pragma unroll
      for (int k = 0; k < 4; ++k) { const float g0 = bf2f(gq[i][k] & 0xFFFFu), g1 = bf2f(gq[i][k] >> 16);
        const float a0 = bf2f(v[k] & 0xFFFFu) * g0 * __builtin_amdgcn_rcpf(1.f + __expf(-g0)), a1 = bf2f(v[k] >> 16) * g1 * __builtin_amdgcn_rcpf(1.f + __expf(-g1)); w[k] = pk2(a0, a1); }
      *(u32x4*)(Ow + (long)row * DMP + ch * 8) = w; } }
  if (fetch_next) {
    const char* Qn = (const char*)(Q + (rowbase + q0 + QB + wid * QBLK) * DMP + hc * 64);
    int l2 = lane; asm volatile("" : "+v"(l2));
    const unsigned qo = (unsigned)((l2 & 31) * DMP + (l2 >> 5) * 8) * 2u;
#pragma unroll
    for (int d0 = 0; d0 < 4; ++d0) qpre[d0] = *reinterpret_cast<const bf16x8*>(Qn + qo + d0 * 32); }
  else {
#pragma unroll
    for (int d0 = 0; d0 < 4; ++d0) qpre[d0] = bf16x8{}; }
  asm volatile("s_waitcnt vmcnt(0) lgkmcnt(0)\n\ts_barrier" ::: "memory");
#undef DMA_K
#undef DMA_V
#undef DMA_M
#undef MROT
#undef CMASK
#undef START
#undef RESC
#undef ROT
#undef TL
#undef SLOT
#undef SLW
#undef QLD
}

#undef SBAR
#undef WAIT_BAR
}

__device__ __forceinline__ void p6_norm(const Prm& P, int vcu, int G) {
    const int tid = opaque_tid(), lane = tid & 63, wave = tid >> 6, gw = vcu * NWAVES + wave, NGW = G * NWAVES;
    const bf16* Y = (const bf16*)(P.ws + WS_Y); bf16* H = (bf16*)(P.ws + WS_H); float* RS1 = (float*)(P.ws + WS_FLG);
    const int rb = G == 256 ? 8192 * (vcu >> 5) : 0, Ml = G == 256 ? 8192 : M, gwl = G == 256 ? (vcu & 31) * NWAVES + wave : gw, NGl = G == 256 ? 32 * NWAVES : NGW;
    for (int ml = gwl; ml < Ml; ml += 2 * NGl) {
        int mr[2]; mr[0] = rb + ml; mr[1] = ml + NGl < Ml ? rb + ml + NGl : rb + ml;
        const f32x4* pg = (const f32x4*)P.post_g + lane;
        unsigned long long yw[2][4]; f32x4 xv[2][4], pgv[4];
#pragma unroll
        for (int i = 0; i < 2; ++i) { const unsigned long long* yr = (const unsigned long long*)(Y + (size_t)mr[i] * DM) + lane; const f32x4* xr = (const f32x4*)(P.x + (size_t)mr[i] * DM) + lane;
#pragma unroll
            for (int j = 0; j < 4; ++j) { yw[i][j] = yr[64 * j]; xv[i][j] = xr[64 * j]; } }
#pragma unroll
        for (int j = 0; j < 4; ++j) pgv[j] = pg[64 * j];
#pragma unroll
        for (int i = 0; i < 2; ++i) {
            f32x4 y[4]; float s = 0.f;
#pragma unroll
            for (int j = 0; j < 4; ++j) { const unsigned long long w = yw[i][j]; y[j] = (f32x4){bf2f((unsigned)w & 0xFFFFu), bf2f(((unsigned)w) >> 16), bf2f((unsigned)(w >> 32) & 0xFFFFu), bf2f((unsigned)(w >> 48))};
                s += (y[j].x * y[j].x + y[j].y * y[j].y) + (y[j].z * y[j].z + y[j].w * y[j].w); }
            const float rs = 1.0f / sqrtf(wave_sum(s) * (1.f / DM) + RMS_EPS);
            float s2 = 0.f;
#pragma unroll
            for (int j = 0; j < 4; ++j) { y[j] = xv[i][j] + y[j] * rs * pgv[j]; s2 += (y[j].x * y[j].x + y[j].y * y[j].y) + (y[j].z * y[j].z + y[j].w * y[j].w); }
            const float rs2 = 1.0f / sqrtf(wave_sum(s2) * (1.f / DM) + RMS_EPS);
            unsigned long long* hr = (unsigned long long*)(H + (size_t)mr[i] * DM) + lane;
#pragma unroll
            for (int j = 0; j < 4; ++j) hr[64 * j] = (unsigned long long)pk2(y[j].x, y[j].y) | ((unsigned long long)pk2(y[j].z, y[j].w) << 32);
            if (lane == 0) RS1[(size_t)mr[i] * 8] = rs2; }
    }
}
__device__ __forceinline__ void p10_final(const Prm& P, int vcu, int G) {
    const int tid = opaque_tid(), lane = tid & 63, wave = tid >> 6, gw = vcu * NWAVES + wave, NGW = G * NWAVES;
    const bf16* Y = (const bf16*)(P.ws + WS_Y); const bf16* H = (const bf16*)(P.ws + WS_H);
    const int rb = G == 256 ? 8192 * (vcu >> 5) : 0, Ml = G == 256 ? 8192 : M, gwl = G == 256 ? (vcu & 31) * NWAVES + wave : gw, NGl = G == 256 ? 32 * NWAVES : NGW;
    for (int ml = gwl; ml < Ml; ml += 2 * NGl) {
        int mr[2]; mr[0] = rb + ml; mr[1] = ml + NGl < Ml ? rb + ml + NGl : rb + ml;
        const f32x4* pg = (const f32x4*)(P.post_g + DM) + lane;
        unsigned long long yw[2][4], hw[2][4]; f32x4 pgv[4];
#pragma unroll
        for (int i = 0; i < 2; ++i) { const unsigned long long* yr = (const unsigned long long*)(Y + (size_t)mr[i] * DM) + lane; const unsigned long long* hr = (const unsigned long long*)(H + (size_t)mr[i] * DM) + lane;
#pragma unroll
            for (int j = 0; j < 4; ++j) { yw[i][j] = yr[64 * j]; hw[i][j] = hr[64 * j]; } }
#pragma unroll
        for (int j = 0; j < 4; ++j) pgv[j] = pg[64 * j];
#pragma unroll
        for (int i = 0; i < 2; ++i) {
            f32x4* orow = (f32x4*)(P.out + (size_t)mr[i] * DM) + lane;
            f32x4 y[4]; float s = 0.f;
#pragma unroll
            for (int j = 0; j < 4; ++j) { const unsigned long long w = yw[i][j]; y[j] = (f32x4){bf2f((unsigned)w & 0xFFFFu), bf2f(((unsigned)w) >> 16), bf2f((unsigned)(w >> 32) & 0xFFFFu), bf2f((unsigned)(w >> 48))};
                s += (y[j].x * y[j].x + y[j].y * y[j].y) + (y[j].z * y[j].z + y[j].w * y[j].w); }
            const float rs = 1.0f / sqrtf(wave_sum(s) * (1.f / DM) + RMS_EPS);
#pragma unroll
            for (int j = 0; j < 4; ++j) { const unsigned long long w = hw[i][j]; const f32x4 x1 = (f32x4){bf2f((unsigned)w & 0xFFFFu), bf2f(((unsigned)w) >> 16), bf2f((unsigned)(w >> 32) & 0xFFFFu), bf2f((unsigned)(w >> 48))};
                orow[64 * j] = x1 + y[j] * rs * pgv[j]; } }
    }
}

constexpr int CW_BAR = 4096;
constexpr int CW_MISMATCH = 3072;
#define XB_TMO      128
#define XB_XCNT(j)  (256  + 64 * (j))
#define XB_XSUB(j)  (1280 + 64 * (j))
#define XB_XGEN(j)  (2304 + 64 * (j))
#define XB_TOP      3328
#define XB_TOPGEN   3392
#define XCD_BAR_WORDS 3456
#define XB_SPIN_CAP (1u << 18)

__device__ __forceinline__ unsigned xb_ld(unsigned* p)              { return __hip_atomic_load(p, __ATOMIC_RELAXED, __HIP_MEMORY_SCOPE_AGENT); }
__device__ __forceinline__ unsigned xb_add(unsigned* p, unsigned v) { return __hip_atomic_fetch_add(p, v, __ATOMIC_RELAXED, __HIP_MEMORY_SCOPE_AGENT); }
__device__ __forceinline__ unsigned xb_xcc_id() { return (unsigned)__builtin_amdgcn_s_getreg((3 << 11) | 20) & 0xFu; }
#define XB_SPIN(cond, bar) do { unsigned _sp = 0; while (cond) { __builtin_amdgcn_s_sleep(1); \
    if ((++_sp & 255u) == 0u) { if (xb_ld(&(bar)[XB_TMO])) break; if (_sp > XB_SPIN_CAP) { atomicAdd(&(bar)[XB_TMO], 1u); break; } } } } while (0)

struct XcdBarrier {
    unsigned* bar; unsigned x;
    volatile LAS unsigned* st;
};

__device__ __forceinline__ XcdBarrier xcd_barrier_post(unsigned* bar, volatile LAS unsigned* st) {
    XcdBarrier b; b.bar = bar; b.x = xb_xcc_id(); b.st = st;
    if (threadIdx.x == 0) (void)xb_add(&bar[XB_XCNT(b.x)], 1u);
    return b;
}
__device__ __forceinline__ void xcd_barrier_complete(unsigned* bar, unsigned x, unsigned& nloc, unsigned& nx) {
    const unsigned G = gridDim.x * gridDim.y * gridDim.z;
    unsigned sum, cnt, mine, sp = 0u;
    for (;;) {
        sum = 0u; cnt = 0u; mine = 0u;
#pragma unroll
        for (unsigned j = 0; j < 16; ++j) { const unsigned c = xb_ld(&bar[XB_XCNT(j)]); sum += c; cnt += (c > 0u) ? 1u : 0u; mine = (j == x) ? c : mine; }
        if (sum == G) break;
        __builtin_amdgcn_s_sleep(1);
        if ((++sp & 255u) == 0u) { if (xb_ld(&bar[XB_TMO])) break; if (sp > XB_SPIN_CAP) { atomicAdd(&bar[XB_TMO], 1u); break; } }
    }
    nloc = mine > 0u ? mine : 1u; nx = cnt > 0u ? cnt : 1u;
}

__device__ __forceinline__ void xcd_barrier(const XcdBarrier& b, bool local = false) {
    asm volatile("s_waitcnt vmcnt(0)" ::: "memory");
    __syncthreads();
    if (threadIdx.x == 0) {
        unsigned* bar = b.bar;
        __builtin_amdgcn_s_waitcnt(0);
        unsigned nloc = b.st[0], nx = b.st[1];
        if (nloc == 0u) { xcd_barrier_complete(bar, b.x, nloc, nx); b.st[0] = nloc; b.st[1] = nx; }
        const unsigned old = xb_add(&bar[XB_XSUB(b.x)], 1u);
        const unsigned gen = old / nloc;
        if (old + 1u == (gen + 1u) * nloc) {
          if (!local) {
            __builtin_amdgcn_fence(__ATOMIC_RELEASE, "agent");
            asm volatile("s_waitcnt vmcnt(0)" ::: "memory");
            const unsigned og = xb_add(&bar[XB_TOP], 1u);
            const unsigned tg = og / nx;
            if (og + 1u == (tg + 1u) * nx) xb_add(&bar[XB_TOPGEN], 1u);
            else XB_SPIN(xb_ld(&bar[XB_TOPGEN]) == tg, bar);
          }
            __builtin_amdgcn_fence(__ATOMIC_ACQUIRE, "agent");
            xb_add(&bar[XB_XGEN(b.x)], 1u);
            asm volatile("s_waitcnt vmcnt(0)" ::: "memory");
        } else {
            XB_SPIN(xb_ld(&bar[XB_XGEN(b.x)]) == gen, bar);
            __builtin_amdgcn_fence(__ATOMIC_ACQUIRE, "agent");
            asm volatile("s_waitcnt vmcnt(0)" ::: "memory");
        }
    }
    __syncthreads();
}

constexpr int NPHASE = 11;
__global__ void __launch_bounds__(NTHR, 2) fwd(Prm P) {
    extern __shared__ __attribute__((aligned(16))) unsigned char lds_raw[];
    LAS unsigned char* lds = (LAS unsigned char*)lds_raw;
    const int G = gridDim.x, bx = blockIdx.x;
    const int vcu = (G % 8 == 0) ? (bx % 8) * (G / 8) + bx / 8 : bx;
    const int lo = P.ph_lo, hi = P.ph_hi;
    unsigned char* ws = P.ws;
    if (threadIdx.x < 64) ((LAS unsigned*)(lds + MISC_OFF))[threadIdx.x] = 0u;
    __syncthreads();
    XcdBarrier bar; bar.bar = (unsigned*)(ws + WS_CTL) + CW_BAR + P.li * XCD_BAR_WORDS; bar.x = 0; bar.st = nullptr;
    if (hi - lo > 1) bar = xcd_barrier_post((unsigned*)(ws + WS_CTL) + CW_BAR + P.li * XCD_BAR_WORDS, (volatile LAS unsigned*)(lds + MISC_OFF));
#define IN(k) (lo <= (k) && (k) < hi)
#define SEAM(k) do { if (IN(k) && IN((k) + 1)) xcd_barrier(bar, (k) >= 1 && use_local); } while (0)
    bool use_local = false;
    unsigned* mis = (unsigned*)(ws + WS_CTL) + CW_MISMATCH;
    if (G == 256 && IN(0) && IN(1) && threadIdx.x == 0 && bar.x != (unsigned)(bx & 7)) (void)__hip_atomic_fetch_or(mis, 1u, __ATOMIC_RELAXED, __HIP_MEMORY_SCOPE_AGENT);
    if (IN(0)) p0_prologue(P, lds, vcu, G);
    SEAM(0);
    if (G == 256 && IN(0) && IN(1)) use_local = __hip_atomic_load(mis, __ATOMIC_RELAXED, __HIP_MEMORY_SCOPE_AGENT) == 0u;
    if (IN(1)) {
        pg8::Gemm g{(const pg8::bf16_t*)(ws + WS_H), (const pg8::bf16_t*)(ws + WS_W0T), M, N0, 1024}; pg8::StaticOrder S; S.init(M, N0, G, bx); pg8::EpiProj<false> E{ws, P.b_forget, 0, 0, nullptr};
        pg8::gemm_phase<pg8::EpiProj<false>, pg8::StaticOrder, true, true>(lds, g, S, E);
    }
    SEAM(1);
    if (IN(2)) p2_post(P, lds, vcu, G);
    SEAM(2);
    if (IN(3)) {
        p3_indexer(P, lds, vcu, G);
        __syncthreads();
        if (G == 256) {
            unsigned* ctr = (unsigned*)(ws + WS_CTL) + CW_QUEUE + 64 * (vcu >> 4); LAS int* qslot = (LAS int*)(lds + MISC_OFF + 64);
            int nxt = 0; if (threadIdx.x == 0) nxt = (int)__hip_atomic_fetch_add(ctr, 1u, __ATOMIC_RELAXED, __HIP_MEMORY_SCOPE_AGENT);
            bool fet = false; bf16x8 qpre[4]; f32x4 cpre0, cpre1, cpre2, cpre3;
            LAS float* kmt = (LAS float*)(lds + af::LDS_VOTE + 32);
            if (threadIdx.x < 8) kmt[threadIdx.x] = __uint_as_float(__hip_atomic_load((const unsigned*)(ws + WS_CTL) + CW_KMAX + (vcu >> 4) * 8 + threadIdx.x, __ATOMIC_RELAXED, __HIP_MEMORY_SCOPE_AGENT));
            for (;;) {
                if (threadIdx.x == 0) *qslot = nxt;
                __syncthreads();
                const int cur = *qslot;
                if (cur >= 128) break;
                if (threadIdx.x == 0) nxt = (int)__hip_atomic_fetch_add(ctr, 1u, __ATOMIC_RELAXED, __HIP_MEMORY_SCOPE_AGENT);
                af::attn_unit<0, 8>(P, (char*)lds_raw, vcu >> 4, cur & 7, 15 - (cur >> 3), qpre, cpre0, cpre1, cpre2, cpre3, fet, 2, nxt, qslot + 1, kmt); fet = true;
            }
            __syncthreads();
        }
        else { bf16x8 qpre[4]; f32x4 cpre0, cpre1, cpre2, cpre3; for (int u0 = vcu; u0 < NB * 8 * 16; u0 += G) af::attn_unit<0, 8>(P, (char*)lds_raw, u0 >> 7, (u0 >> 4) & 7, u0 & 15, qpre, cpre0, cpre1, cpre2, cpre3); }
    }
    SEAM(3);
    if (IN(4)) {
        if (G == 256) { bf16x8 qpre[4]; f32x4 cpre0, cpre1, cpre2, cpre3; for (int i = 0; i < 8; ++i) { const int bh = vcu >> 1, sidx = 4 * (vcu & 1) + (i >> 1), qb = (i & 1) ? 15 - sidx : sidx, sn = 4 * (vcu & 1) + ((i + 1) >> 1), qn = i == 7 ? -1 : ((i + 1) & 1) ? 15 - sn : sn;
            af::attn_unit<1, 8>(P, (char*)lds_raw, bh >> 3, 8 + (bh & 7), qb, qpre, cpre0, cpre1, cpre2, cpre3, i > 0, 1, qn); } }
        else { bf16x8 qpre[4]; f32x4 cpre0, cpre1, cpre2, cpre3; for (int u0 = vcu; u0 < NB * 8 * 16; u0 += G) af::attn_unit<1, 8>(P, (char*)lds_raw, u0 >> 7, 8 + ((u0 >> 4) & 7), u0 & 15, qpre, cpre0, cpre1, cpre2, cpre3); }
    }
    SEAM(4);
    if (IN(5)) { pg8::Gemm g{(const pg8::bf16_t*)(ws + WS_QQ), (const pg8::bf16_t*)(ws + WS_WO0T), M, 1024, 1024}; pg8::StaticOrder S; S.init(M, 1024, G, bx); pg8::EpiYb E{(pg8::bf16_t*)(ws + WS_Y)};
        pg8::gemm_phase<pg8::EpiYb, pg8::StaticOrder, true, true>(lds, g, S, E); }
    SEAM(5);
    if (IN(6)) p6_norm(P, vcu, G);
    SEAM(6);
    if (IN(7)) { pg8::Gemm g{(const pg8::bf16_t*)(ws + WS_H), (const pg8::bf16_t*)(ws + WS_W1T), M, N1, 1024}; pg8::StaticOrder S; S.init(M, N1, G, bx); pg8::EpiProj<false> E{ws, nullptr, 0, 0, (const float*)(ws + WS_FLG)};
        pg8::gemm_phase<pg8::EpiProj<false>, pg8::StaticOrder, true, true>(lds, g, S, E); }
    SEAM(7);
    if (IN(8)) {
        if (G == 256) { bf16x8 qpre[4]; for (int qb = 0; qb < 16; ++qb) af::attn_band_unit(P, (char*)lds_raw, vcu >> 4, vcu & 15, qb, qpre, qb > 0, qb < 15); }
        else { bf16x8 qpre[4]; f32x4 cpre0, cpre1, cpre2, cpre3; for (int u0 = vcu; u0 < NB * 16 * 16; u0 += G) af::attn_unit<2, 8>(P, (char*)lds_raw, u0 >> 8, (u0 >> 4) & 15, u0 & 15, qpre, cpre0, cpre1, cpre2, cpre3); }
    }
    SEAM(8);
    if (IN(9)) { pg8::Gemm g{(const pg8::bf16_t*)(ws + WS_QQ), (const pg8::bf16_t*)(ws + WS_WO1T), M, 1024, 1024}; pg8::StaticOrder S; S.init(M, 1024, G, bx); pg8::EpiYb E{(pg8::bf16_t*)(ws + WS_Y)};
        pg8::gemm_phase<pg8::EpiYb, pg8::StaticOrder, true, true>(lds, g, S, E); }
    SEAM(9);
    if (IN(10)) p10_final(P, vcu, G);
#undef IN
#undef SEAM
}

extern "C" void kernel_launch(void* const* d_in, const int* in_sizes, int n_in, void* d_out, int out_size, void* d_ws, size_t ws_size, hipStream_t stream) {
    static int grid = 0;
    if (grid == 0) {
        if (n_in != 12 || in_sizes[0] != M * DM || out_size != M * DM || ws_size < WS_END) { fprintf(stderr, "kernel_launch: unexpected shapes (n_in %d, ws %zu)\n", n_in, ws_size); grid = -1; return; }
        int dev = 0, cus = 0;
        if (hipGetDevice(&dev) != hipSuccess || hipDeviceGetAttribute(&cus, hipDeviceAttributeMultiprocessorCount, dev) != hipSuccess) { grid = -1; return; }
        if (hipFuncSetAttribute((const void*)fwd, hipFuncAttributeMaxDynamicSharedMemorySize, LDS_BYTES) != hipSuccess) { grid = -1; return; }
        grid = cus;
    }
    if (grid < 0) return;
    Prm p{};
    p.x = (const float*)d_in[0]; p.pos = (const int*)d_in[1]; p.pre_g = (const float*)d_in[2]; p.post_g = (const float*)d_in[3]; p.w_in0 = (const float*)d_in[4];
    p.b_forget = (const float*)d_in[5]; p.ikg = (const float*)d_in[6]; p.ikb = (const float*)d_in[7]; p.w_out0 = (const float*)d_in[8]; p.w_in1 = (const float*)d_in[9];
    p.rel = (const float*)d_in[10]; p.w_out1 = (const float*)d_in[11];
    p.out = (float*)d_out; p.ws = (unsigned char*)d_ws;
    if (hipMemsetAsync((char*)d_ws + WS_CTL, 0, CTL_ZERO_BYTES, stream) != hipSuccess) return;
#if defined(MK_PER_PHASE)
    for (int ph = 0; ph < NPHASE; ++ph) { p.ph_lo = ph; p.ph_hi = ph + 1; hipLaunchKernelGGL(fwd, dim3(grid), dim3(NTHR), LDS_BYTES, stream, p); }
#elif defined(REP_PHASE)
    { const bool attn = (REP_PHASE == 4 || REP_PHASE == 8);
      p.ph_lo = 0; p.ph_hi = attn ? REP_PHASE : REP_PHASE + 1; p.li = 0; hipLaunchKernelGGL(fwd, dim3(grid), dim3(NTHR), LDS_BYTES, stream, p);
      p.ph_lo = REP_PHASE; p.ph_hi = REP_PHASE + 1; p.li = 1; p.o_alt = attn ? 1 : 0; hipLaunchKernelGGL(fwd, dim3(grid), dim3(NTHR), LDS_BYTES, stream, p); p.o_alt = 0;
      p.ph_lo = attn ? REP_PHASE : REP_PHASE + 1; p.ph_hi = NPHASE; p.li = 2; if (p.ph_lo < NPHASE) hipLaunchKernelGGL(fwd, dim3(grid), dim3(NTHR), LDS_BYTES, stream, p); }
#else
    p.ph_lo = 0; p.ph_hi = NPHASE;
    hipLaunchKernelGGL(fwd, dim3(grid), dim3(NTHR), LDS_BYTES, stream, p);
#endif
}
```

```cpp
#include <hip/hip_runtime.h>
#include <cstdio>
#include <cstdint>
#include <cmath>

#define GAS __attribute__((address_space(1)))
#define LAS __attribute__((address_space(3)))
typedef unsigned short bf16;
typedef short bf16x8 __attribute__((ext_vector_type(8)));
typedef short s16x4 __attribute__((ext_vector_type(4)));
typedef float f32x4 __attribute__((ext_vector_type(4)));
typedef float f32x16 __attribute__((ext_vector_type(16)));
typedef unsigned u32x4 __attribute__((ext_vector_type(4)));
typedef unsigned u32x2 __attribute__((ext_vector_type(2)));

constexpr int NB = 16, SEQ = 4096, DM = 1024, M = NB * SEQ;
constexpr int N0 = 4864;
constexpr int N1 = 4096;
constexpr float LOG2E = 1.4426950408889634f;
constexpr float C2 = 0.125f * LOG2E;
constexpr float RMS_EPS = 1e-6f, LN_EPS = 1e-6f;
constexpr float IDX_SCALE = 0.04419417382415922f;
constexpr int TOPK = 256;
constexpr int NWAVES = 8, NTHR = 512;

constexpr size_t MiB = 1u << 20;
constexpr size_t WS_CTL = 0, CTL_ZERO_BYTES = 64 * 1024;
constexpr size_t WS_W0T = 1 * MiB;
constexpr size_t WS_WO0T = 11 * MiB;
constexpr size_t WS_W1T = 13 * MiB;
constexpr size_t WS_WO1T = 21 * MiB;
constexpr size_t WS_FLG = 23 * MiB;
constexpr size_t WS_IW = 25 * MiB;
constexpr size_t WS_IKRAW = 27 * MiB;
constexpr size_t WS_IK = 43 * MiB;
constexpr size_t WS_FL = 51 * MiB;
constexpr size_t WS_COS = 53 * MiB;
constexpr size_t WS_SIN = 55 * MiB;
constexpr size_t WS_MASK = 57 * MiB;
constexpr size_t WS_H = 96 * MiB;
constexpr size_t WS_QQ = 224 * MiB;
constexpr size_t WS_KK = 352 * MiB;
constexpr size_t WS_VV = 480 * MiB;
constexpr size_t WS_GG = 608 * MiB;
constexpr size_t WS_IQ = 736 * MiB;
constexpr size_t WS_Y = 800 * MiB;
constexpr size_t WS_END = 928 * MiB;
static_assert(WS_MASK + (size_t)M * 512 <= WS_H && WS_IQ + (size_t)M * 1024 <= WS_Y, "ws map");

constexpr int CW_QUEUE = 2048;
constexpr int CW_KMAX = 1024;
constexpr int LDS_BYTES = 163840;
constexpr int MISC_OFF = LDS_BYTES - 256;

struct Prm {
    const float* x; const int* pos; const float* pre_g; const float* post_g; const float* w_in0; const float* b_forget; const float* ikg; const float* ikb;
    const float* w_out0; const float* w_in1; const float* rel; const float* w_out1;
    float* out; unsigned char* ws;
    int ph_lo, ph_hi, li, o_alt;
};

__device__ __forceinline__ int crow(int r, int hi) { return (r & 3) + 8 * (r >> 2) + 4 * hi; }
__device__ __forceinline__ unsigned f2bf(float f) { unsigned u = __builtin_bit_cast(unsigned, f); return (u + 0x7fffu + ((u >> 16) & 1u)) >> 16; }
__device__ __forceinline__ float bf2f(unsigned h) { return __builtin_bit_cast(float, h << 16); }
__device__ __forceinline__ unsigned pk2(float lo, float hi) { return f2bf(lo) | (f2bf(hi) << 16); }
__device__ __forceinline__ float wave_sum(float v) {
#pragma unroll
    for (int o = 1; o < 64; o <<= 1) v += __shfl_xor(v, o);
    return v;
}
__device__ __forceinline__ float silu(float g) { return g / (1.f + __expf(-g)); }
__device__ __forceinline__ float log_sigmoid(float v) { return fminf(v, 0.f) - log1pf(expf(-fabsf(v))); }
__device__ __forceinline__ int opaque_tid() { int t = threadIdx.x; asm volatile("" : "+v"(t)); return t; }

#define DIAG_T0(P) do {} while (0)
#define DIAG_ACC(P, k) do {} while (0)
__device__ __forceinline__ int w0_src_col(int n) {
    if (n < 4096) { const int seg = n >> 9, off = n & 511;
        const int base = seg == 0 ? 0 : seg == 1 ? 2056 : seg == 2 ? 512 : seg == 3 ? 2568 : seg == 4 ? 1024 : seg == 5 ? 3080 : seg == 6 ? 1544 : 4176;
        return base + off; }
    if (n < 4608) return 3592 + (n - 4096);
    if (n < 4672) return 4104 + (n - 4608);
    if (n < 4680) return 1536 + (n - 4672);
    if (n < 4688) return 4168 + (n - 4680);
    return -1;
}
template <bool MAP0>
__device__ __forceinline__ void transpose_item(const float* W, int Nsrc, int Ndst, bf16* WT, LAS float* scr, int item, int lane, const float* kg = nullptr) {
    const int nblk = Ndst / 32, kb = item / nblk, nb = item % nblk, k0 = 64 * kb, n0 = 32 * nb;
    const int nd = n0 + (lane & 31); const int ns = MAP0 ? w0_src_col(nd) : nd;
#pragma unroll 8
    for (int i = 0; i < 32; ++i) { const int kk = 2 * i + (lane >> 5); scr[kk * 33 + (lane & 31)] = ns >= 0 ? W[(size_t)(k0 + kk) * Nsrc + ns] * (kg ? kg[k0 + kk] : 1.f) : 0.f; }
    asm volatile("s_waitcnt lgkmcnt(0)" ::: "memory");
    const int c = lane & 7;
#pragma unroll
    for (int j = 0; j < 4; ++j) { const int n = (lane >> 3) + 8 * j; const LAS float* s = scr + (8 * c) * 33 + n;
        u32x4 o; o.x = pk2(s[0 * 33], s[1 * 33]); o.y = pk2(s[2 * 33], s[3 * 33]); o.z = pk2(s[4 * 33], s[5 * 33]); o.w = pk2(s[6 * 33], s[7 * 33]);
        *(u32x4*)(WT + (size_t)(n0 + n) * 1024 + k0 + 8 * c) = o; }
    asm volatile("s_waitcnt lgkmcnt(0)" ::: "memory");
}
__device__ __forceinline__ void rms_rows_to_bf16(const float* srcA, const float* srcB, const float* g, bf16* dstA, bf16* dstB, int lane) {
    const f32x4* gr = (const f32x4*)g + lane;
    f32x4 v[2][4];
#pragma unroll
    for (int i = 0; i < 2; ++i) { const f32x4* xr = (const f32x4*)(i ? srcB : srcA) + lane;
#pragma unroll
        for (int j = 0; j < 4; ++j) v[i][j] = xr[64 * j]; }
    f32x4 gg[4];
#pragma unroll
    for (int j = 0; j < 4; ++j) gg[j] = gr[64 * j];
#pragma unroll
    for (int i = 0; i < 2; ++i) { float s = 0.f;
#pragma unroll
        for (int j = 0; j < 4; ++j) s += (v[i][j].x * v[i][j].x + v[i][j].y * v[i][j].y) + (v[i][j].z * v[i][j].z + v[i][j].w * v[i][j].w);
        const float rs = 1.0f / sqrtf(wave_sum(s) * (1.f / DM) + RMS_EPS);
        unsigned long long* o8 = (unsigned long long*)(i ? dstB : dstA) + lane;
#pragma unroll
        for (int j = 0; j < 4; ++j)
            o8[64 * j] = (unsigned long long)pk2(v[i][j].x * rs * gg[j].x, v[i][j].y * rs * gg[j].y) | ((unsigned long long)pk2(v[i][j].z * rs * gg[j].z, v[i][j].w * rs * gg[j].w) << 32); }
}
__device__ __forceinline__ void p0_prologue(const Prm& P, LAS unsigned char* lds, int vcu, int G) {
    const int tid = opaque_tid(), lane = tid & 63, wave = tid >> 6;
    LAS float* scr = (LAS float*)(lds + wave * 16384);
    const int gw = vcu * NWAVES + wave, NGW = G * NWAVES;
    unsigned char* ws = P.ws;
    constexpr int I0 = 16 * (N0 / 32), IO = 16 * 32, I1 = 16 * (N1 / 32);
    constexpr int NIT = I0 + IO + I1 + IO;
    for (int it = gw; it < NIT; it += NGW) {
        int r = it;
        if (r < I0) { transpose_item<true>(P.w_in0, 4688, N0, (bf16*)(ws + WS_W0T), scr, r, lane); continue; } r -= I0;
        if (r < IO) { transpose_item<false>(P.w_out0, 1024, 1024, (bf16*)(ws + WS_WO0T), scr, r, lane); continue; } r -= IO;
        if (r < I1) { transpose_item<false>(P.w_in1, N1, N1, (bf16*)(ws + WS_W1T), scr, r, lane, P.pre_g + DM); continue; } r -= I1;
        transpose_item<false>(P.w_out1, 1024, 1024, (bf16*)(ws + WS_WO1T), scr, r, lane);
    }
    bf16* H = (bf16*)(ws + WS_H);
    for (int m = gw; m < M; m += 2 * NGW) { const int m2 = m + NGW < M ? m + NGW : m; rms_rows_to_bf16(P.x + (size_t)m * DM, P.x + (size_t)m2 * DM, P.pre_g, H + (size_t)m * DM, H + (size_t)m2 * DM, lane); }
    float* COS = (float*)(ws + WS_COS); float* SIN = (float*)(ws + WS_SIN);
    for (int idx = vcu * NTHR + tid; idx < M * 8; idx += G * NTHR) {
        const int m = idx >> 3, j = idx & 7;
        const float inv_freq = powf(500000.0f, -(float)j * 0.125f);
        const float ang = (float)P.pos[m] * inv_freq;
        COS[idx] = cosf(ang); SIN[idx] = sinf(ang);
    }
}

namespace pg8 {
#define PG8_LAS __attribute__((address_space(3)))
typedef unsigned short bf16_t;
typedef short bf16x8 __attribute__((ext_vector_type(8)));
typedef float f32x4 __attribute__((ext_vector_type(4)));
typedef unsigned u32x4 __attribute__((ext_vector_type(4)));
constexpr int BM = 256, BK = 64, HALF = 128, HTB = HALF * BK * 2  , STAGE_BYTES = 8 * HTB, NXCD = 8, WGM = 8;

__host__ __device__ __forceinline__ int lds_byte(int r, int c) { const int st = (r >> 4) * 2 + (c >> 5), rr = r & 15, cc = c & 31, ob = rr * 64 + cc * 2; return st * 1024 + (ob ^ (((ob >> 9) & 1) << 5)); }
__host__ __device__ __forceinline__ void stage_rc(int b, int& R, int& C) { const int st = b / 1024, sb = b % 1024, swz = sb ^ (((sb >> 9) & 1) << 5); R = (st >> 1) * 16 + swz / 64; C = (st & 1) * 32 + (swz % 64) / 2; }
__host__ __device__ __forceinline__ int perm32(int rho) { const int n = rho >> 4, i = rho & 15; return 8 * (i >> 2) + 4 * n + (i & 3); }

struct Unit { int pm, pn; };
struct Gemm { const bf16_t* A; const bf16_t* Bt; int M, N, K; };

struct StaticOrder {
    int nM, nN, nwg, G, c;
    __host__ __device__ void init(int M, int N, int G_, int c_) { nM = M / BM; nN = N / BM; nwg = nM * nN; G = G_; c = c_; }
    __host__ __device__ bool next(int i, Unit& u) const {
        const long L = (long)i * G + c; if (L >= nwg) return false;
        int wgid = (int)L; { const int q = nwg / NXCD, r = nwg % NXCD, xcd = wgid % NXCD, off = wgid / NXCD; wgid = (xcd < r ? xcd * (q + 1) : r * (q + 1) + (xcd - r) * q) + off; }
        const int nig = WGM * nN, gid = wgid / nig, fm = gid * WGM, gsz = (nM - fm) < WGM ? (nM - fm) : WGM;
        u.pm = fm + ((wgid % nig) % gsz); u.pn = (wgid % nig) / gsz; return true;
    }
    __device__ __forceinline__ void a_ready(const Unit&) const {}
    __device__ __forceinline__ void done(const Unit&) const {}
};

__device__ __forceinline__ unsigned cvt_pk_bf16(float lo, float hi) { unsigned r; asm volatile("v_cvt_pk_bf16_f32 %0, %1, %2" : "=v"(r) : "v"(lo), "v"(hi)); return r; }

template <class Epi, class Sched, bool ALIGN_EPI = false, bool SP2 = false>
__device__ __forceinline__ void gemm_phase(PG8_LAS unsigned char* lds, const Gemm g, const Sched& S, const Epi& E) {
    const int tid = threadIdx.x, wid = __builtin_amdgcn_readfirstlane(tid >> 6), lane = tid & 63, wr = wid >> 2, wc = wid & 3, fr = lane & 15, fq = lane >> 4;
    const int K = g.K, nt = K / BK;
    unsigned voffA[2], voffB[2];
#pragma unroll
    for (int i = 0; i < 2; ++i) { int R, C; stage_rc(tid * 16 + i * 8192, R, C); const int Rb = Epi::PERM ? ((R & ~31) + perm32(R & 31)) : R;
        voffA[i] = (unsigned)(R * K + C) * 2u; voffB[i] = (unsigned)(Rb * K + C) * 2u; }
    const size_t kstep = (size_t)(BK * 2);
    const size_t hstep = (size_t)HALF * K * 2;
    const size_t tstep = 2 * hstep;
    const unsigned ldsw = (unsigned)wid * 1024u;
    const int aoff = lds_byte(wr * 64 + fr, fq * 8), boff = lds_byte(wc * 32 + fr, fq * 8);
#define PG8_SA(b, h) (((b) * 2 + (h)) * HTB)
#define PG8_SB(b, h) ((4 + (b) * 2 + (h)) * HTB)
#define PG8_STAGE(bufoff, gbase, voff) do { _Pragma("unroll") for (int _i = 0; _i < 2; ++_i) \
        __builtin_amdgcn_global_load_lds((const unsigned*)((const char*)(gbase) + (voff)[_i]), (PG8_LAS unsigned*)(lds + (bufoff) + ldsw + _i * 8192), 16, 0, 0); } while (0)
#define PG8_LDA(dst, b, h) do { _Pragma("unroll") for (int m = 0; m < 4; ++m) _Pragma("unroll") for (int k = 0; k < 2; ++k) dst[m][k] = *(const PG8_LAS bf16x8*)(lds + PG8_SA(b, h) + aoff + m * 2048 + k * 1024); } while (0)
#define PG8_LDB(dst, b, h) do { _Pragma("unroll") for (int n = 0; n < 2; ++n) _Pragma("unroll") for (int k = 0; k < 2; ++k) dst[n][k] = *(const PG8_LAS bf16x8*)(lds + PG8_SB(b, h) + boff + n * 2048 + k * 1024); } while (0)
#define PG8_MMA(ai, bj, At, Bt) do { __builtin_amdgcn_s_setprio(1); _Pragma("unroll") for (int m = 0; m < 4; ++m) _Pragma("unroll") for (int n = 0; n < 2; ++n) _Pragma("unroll") for (int k = 0; k < 2; ++k) \
        acc[ai][bj][m][n] = __builtin_amdgcn_mfma_f32_16x16x32_bf16(Bt[n][k], At[m][k], acc[ai][bj][m][n], 0, 0, 0); __builtin_amdgcn_s_setprio(0); } while (0)
#define PG8_WAIT_V(n) asm volatile("s_waitcnt vmcnt(" #n ")" ::: "memory")
#define PG8_WAIT_L(n) asm volatile("s_waitcnt lgkmcnt(" #n ")" ::: "memory")
#define PG8_BAR __builtin_amdgcn_s_barrier()
#define PG8_SCHED __builtin_amdgcn_sched_barrier(0)
    Unit cur, nxt; int ui = 0;
    if (!S.next(0, cur)) return;
    f32x4 acc[2][2][4][2];
#pragma unroll
    for (int a = 0; a < 2; ++a)
#pragma unroll
        for (int b = 0; b < 2; ++b)
#pragma unroll
            for (int m = 0; m < 4; ++m)
#pragma unroll
                for (int n = 0; n < 2; ++n) acc[a][b][m][n] = (f32x4){0.f, 0.f, 0.f, 0.f};
    bf16x8 At[4][2], B0[2][2], B1[2][2];
    const char* cA = (const char*)g.A + (size_t)cur.pm * tstep; const char* cB = (const char*)g.Bt + (size_t)cur.pn * tstep;
    S.a_ready(cur);
    if constexpr (SP2) {
        PG8_STAGE(PG8_SB(0, 0), cB, voffB); PG8_STAGE(PG8_SB(0, 1), cB + hstep, voffB); PG8_STAGE(PG8_SA(0, 0), cA, voffA); PG8_STAGE(PG8_SA(0, 1), cA + hstep, voffA);
        if (wr == 1) PG8_BAR;
        PG8_WAIT_V(2); PG8_BAR;
        PG8_STAGE(PG8_SB(1, 0), cB + kstep, voffB); PG8_STAGE(PG8_SA(1, 0), cA + kstep, voffA); PG8_STAGE(PG8_SB(1, 1), cB + hstep + kstep, voffB);
        PG8_WAIT_V(6); PG8_BAR;
    } else {
        PG8_STAGE(PG8_SB(0, 0), cB, voffB); PG8_STAGE(PG8_SA(0, 0), cA, voffA); PG8_STAGE(PG8_SB(0, 1), cB + hstep, voffB); PG8_STAGE(PG8_SA(0, 1), cA + hstep, voffA);
        if (wr == 1) PG8_BAR;
        PG8_WAIT_V(4); PG8_BAR;
        PG8_STAGE(PG8_SB(1, 0), cB + kstep, voffB); PG8_STAGE(PG8_SA(1, 0), cA + kstep, voffA); PG8_STAGE(PG8_SB(1, 1), cB + hstep + kstep, voffB);
        PG8_WAIT_V(6); PG8_BAR;
    }
    for (;;) {
        const bool has_next = S.next(ui + 1, nxt);
        const char* nA = has_next ? (const char*)g.A + (size_t)nxt.pm * tstep : cA; const char* nB = has_next ? (const char*)g.Bt + (size_t)nxt.pn * tstep : cB;
        for (int t = 0; t < nt; t += 2) {
            const bool last = (t == nt - 2);
            const char* a1 = cA + (size_t)(t + 1) * kstep;
            const char* a2 = last ? nA : cA + (size_t)(t + 2) * kstep; const char* b2 = last ? nB : cB + (size_t)(t + 2) * kstep;
            const char* a3 = a2 + kstep; const char* b3 = b2 + kstep;
            if (last && has_next) S.a_ready(nxt);
            if constexpr (SP2) {
            PG8_LDB(B0, 0, 0); PG8_LDB(B1, 0, 1); PG8_SCHED; PG8_LDA(At, 0, 0); PG8_STAGE(PG8_SA(1, 1), a1 + hstep, voffA);
            PG8_WAIT_V(8); PG8_WAIT_L(0); PG8_BAR; PG8_MMA(0, 0, At, B0); PG8_MMA(0, 1, At, B1); PG8_BAR; PG8_SCHED;
            PG8_LDA(At, 0, 1); PG8_STAGE(PG8_SB(0, 0), b2, voffB); PG8_STAGE(PG8_SB(0, 1), b2 + hstep, voffB); PG8_STAGE(PG8_SA(0, 0), a2, voffA);
            PG8_WAIT_V(8); PG8_WAIT_L(0); PG8_BAR; PG8_MMA(1, 0, At, B0); PG8_MMA(1, 1, At, B1); PG8_BAR; PG8_SCHED;
            PG8_LDB(B0, 1, 0); PG8_LDB(B1, 1, 1); PG8_SCHED; PG8_LDA(At, 1, 0); PG8_STAGE(PG8_SA(0, 1), a2 + hstep, voffA);
            PG8_WAIT_V(8); PG8_WAIT_L(0); PG8_BAR; PG8_MMA(0, 0, At, B0); PG8_MMA(0, 1, At, B1); PG8_BAR; PG8_SCHED;
            PG8_LDA(At, 1, 1); PG8_STAGE(PG8_SB(1, 0), b3, voffB); PG8_STAGE(PG8_SB(1, 1), b3 + hstep, voffB); PG8_STAGE(PG8_SA(1, 0), a3, voffA);
            PG8_WAIT_V(8); PG8_WAIT_L(0); PG8_BAR; PG8_MMA(1, 0, At, B0); PG8_MMA(1, 1, At, B1); PG8_BAR; PG8_SCHED;
            } else {
            PG8_LDB(B0, 0, 0); PG8_SCHED; PG8_LDA(At, 0, 0); PG8_STAGE(PG8_SA(1, 1), a1 + hstep, voffA);
            PG8_WAIT_L(8); PG8_BAR; PG8_WAIT_L(0); PG8_MMA(0, 0, At, B0); PG8_BAR; PG8_SCHED;
            PG8_LDB(B1, 0, 1); PG8_STAGE(PG8_SB(0, 0), b2, voffB);
            PG8_BAR; PG8_WAIT_L(0); PG8_MMA(0, 1, At, B1); PG8_BAR;
            PG8_LDA(At, 0, 1); PG8_STAGE(PG8_SA(0, 0), a2, voffA);
            PG8_BAR; PG8_WAIT_L(0); PG8_MMA(1, 0, At, B0); PG8_BAR; PG8_SCHED;
            PG8_STAGE(PG8_SB(0, 1), b2 + hstep, voffB);
            PG8_WAIT_V(6); PG8_BAR; PG8_MMA(1, 1, At, B1); PG8_BAR;
            PG8_LDB(B0, 1, 0); PG8_SCHED; PG8_LDA(At, 1, 0); PG8_STAGE(PG8_SA(0, 1), a2 + hstep, voffA);
            PG8_WAIT_L(8); PG8_BAR; PG8_WAIT_L(0); PG8_MMA(0, 0, At, B0); PG8_BAR; PG8_SCHED;
            PG8_LDB(B1, 1, 1); PG8_STAGE(PG8_SB(1, 0), b3, voffB);
            PG8_BAR; PG8_WAIT_L(0); PG8_MMA(0, 1, At, B1); PG8_BAR;
            PG8_LDA(At, 1, 1); PG8_STAGE(PG8_SA(1, 0), a3, voffA);
            PG8_BAR; PG8_WAIT_L(0); PG8_MMA(1, 0, At, B0); PG8_BAR; PG8_SCHED;
            PG8_STAGE(PG8_SB(1, 1), b3 + hstep, voffB);
            PG8_WAIT_V(6); PG8_BAR; PG8_MMA(1, 1, At, B1); PG8_BAR;
            }
        }
        if constexpr (ALIGN_EPI) { if (wr == 0) PG8_BAR; }
        if constexpr (!Epi::AFTER_DRAIN) { E(acc, cur, wr, wc, fr, fq); S.done(cur); }
        if (!has_next) break;
#pragma unroll
        for (int a = 0; a < 2; ++a)
#pragma unroll
            for (int b = 0; b < 2; ++b)
#pragma unroll
                for (int m = 0; m < 4; ++m)
#pragma unroll
                    for (int n = 0; n < 2; ++n) acc[a][b][m][n] = (f32x4){0.f, 0.f, 0.f, 0.f};
        cur = nxt; cA = nA; cB = nB; ++ui;
        if constexpr (ALIGN_EPI) { if (wr == 1) PG8_BAR; }
    }
    PG8_WAIT_V(0);
    if constexpr (!ALIGN_EPI) { if (wr == 0) PG8_BAR; }
    PG8_BAR;
    if constexpr (Epi::AFTER_DRAIN) { E.fused(acc, cur, wr, wc, fr, fq, lds, wid, lane); S.done(cur); }
#undef PG8_SA
#undef PG8_SB
#undef PG8_STAGE
#undef PG8_LDA
#undef PG8_LDB
#undef PG8_MMA
#undef PG8_WAIT_V
#undef PG8_WAIT_L
#undef PG8_BAR
#undef PG8_SCHED
}


template <bool ROPE>
struct EpiProj {
    static constexpr bool PERM = true, AFTER_DRAIN = false;
    unsigned char* ws; const float* b_forget; int col_off; int rope_on; const float* rowscale;
    __device__ __forceinline__ void operator()(const f32x4 (&acc)[2][2][4][2], const Unit& u, int wr, int wc, int fr, int fq) const {
        const int row0 = u.pm * BM + wr * 64 + fr, colt = col_off + u.pn * BM, lc0 = wc * 32 + 8 * fq;
        if (colt < 4608) {
            bf16_t* base; int pitch; float sc = 1.f;
            if (colt < 4096) { const int t = colt >> 10; base = (bf16_t*)(ws + WS_QQ + (size_t)t * (WS_KK - WS_QQ)) + (colt & 1023) + lc0; pitch = 1024; if (t == 0) sc = C2; }
            else { base = (bf16_t*)(ws + WS_IQ) + (colt - 4096) + lc0; pitch = 512; }
            const bool rope = ROPE && rope_on && !(wc & 1) && ((colt >= 512 && colt < 1024) || (colt >= 1536 && colt < 2048) || colt >= 4096);
            float rsc[2][4];
#pragma unroll
            for (int ai = 0; ai < 2; ++ai)
#pragma unroll
                for (int m = 0; m < 4; ++m) rsc[ai][m] = rowscale ? rowscale[(size_t)(row0 + ai * HALF + m * 16) * 8] * sc : sc;
#pragma unroll
            for (int ai = 0; ai < 2; ++ai) {
                f32x4 cs[4][4];
                if (rope) {
#pragma unroll
                    for (int m = 0; m < 4; ++m) { const size_t row = (size_t)(row0 + ai * HALF + m * 16); const float* cp = (const float*)(ws + WS_COS) + row * 8; const float* sp = (const float*)(ws + WS_SIN) + row * 8;
                        cs[m][0] = *(const f32x4*)cp; cs[m][1] = *(const f32x4*)(cp + 4); cs[m][2] = *(const f32x4*)sp; cs[m][3] = *(const f32x4*)(sp + 4);
                        if (fq == 0) { cs[m][2] = -cs[m][2]; cs[m][3] = -cs[m][3]; } }
                }
#pragma unroll
                for (int m = 0; m < 4; ++m) { const size_t row = (size_t)(row0 + ai * HALF + m * 16); bf16_t* rowp = base + row * pitch;
#pragma unroll
                    for (int bj = 0; bj < 2; ++bj) { f32x4 v0 = acc[ai][bj][m][0], v1 = acc[ai][bj][m][1];
                        if (rope) { f32x4 o0, o1;
#pragma unroll
                            for (int i = 0; i < 4; ++i) { o0[i] = __shfl_xor(v0[i], 16); o1[i] = __shfl_xor(v1[i], 16); }
                            if (fq < 2) { v0 = v0 * cs[m][0] + o0 * cs[m][2]; v1 = v1 * cs[m][1] + o1 * cs[m][3]; } }
                        v0 = v0 * rsc[ai][m]; v1 = v1 * rsc[ai][m];
                        u32x4 w; w.x = cvt_pk_bf16(v0[0], v0[1]); w.y = cvt_pk_bf16(v0[2], v0[3]); w.z = cvt_pk_bf16(v1[0], v1[1]); w.w = cvt_pk_bf16(v1[2], v1[3]);
                        *(u32x4*)(rowp + bj * HALF) = w; } } }
        } else {
#pragma unroll
            for (int ai = 0; ai < 2; ++ai)
#pragma unroll
                for (int m = 0; m < 4; ++m) { const size_t row = (size_t)(row0 + ai * HALF + m * 16);
#pragma unroll
                    for (int bj = 0; bj < 2; ++bj) { const int lc = bj * HALF + lc0; f32x4 v0 = acc[ai][bj][m][0], v1 = acc[ai][bj][m][1];
                        float* dst = nullptr;
                        if (lc < 64) dst = (float*)(ws + WS_IKRAW) + row * 64 + lc;
                        else if (lc == 64) dst = (float*)(ws + WS_FLG) + row * 8;
                        else if (lc == 72) { dst = (float*)(ws + WS_IW) + row * 8; v0 = v0 * IDX_SCALE; v1 = v1 * IDX_SCALE; }
                        if (dst) { *(f32x4*)dst = v0; *(f32x4*)(dst + 4) = v1; } } }
        }
    }
};
struct EpiYb {
    static constexpr bool PERM = true, AFTER_DRAIN = false;
    bf16_t* Y;
    __device__ __forceinline__ void operator()(const f32x4 (&acc)[2][2][4][2], const Unit& u, int wr, int wc, int fr, int fq) const {
        const int row0 = u.pm * BM + wr * 64 + fr; bf16_t* base = Y + u.pn * BM + wc * 32 + 8 * fq;
#pragma unroll
        for (int ai = 0; ai < 2; ++ai)
#pragma unroll
            for (int m = 0; m < 4; ++m) { bf16_t* rowp = base + (size_t)(row0 + ai * HALF + m * 16) * 1024;
#pragma unroll
                for (int bj = 0; bj < 2; ++bj) { const f32x4 v0 = acc[ai][bj][m][0], v1 = acc[ai][bj][m][1];
                    u32x4 w; w.x = cvt_pk_bf16(v0[0], v0[1]); w.y = cvt_pk_bf16(v0[2], v0[3]); w.z = cvt_pk_bf16(v1[0], v1[1]); w.w = cvt_pk_bf16(v1[2], v1[3]);
                    *(u32x4*)(rowp + bj * HALF) = w; } }
    }
};
}

__device__ __forceinline__ float wave_incl_scan_f(float x) {
#define WSF_STEP(ctrl, rm, bc) x += __builtin_bit_cast(float, __builtin_amdgcn_update_dpp(0, __builtin_bit_cast(int, x), ctrl, rm, 0xF, bc))
    WSF_STEP(0x111, 0xF, true); WSF_STEP(0x112, 0xF, true); WSF_STEP(0x114, 0xF, true); WSF_STEP(0x118, 0xF, true); WSF_STEP(0x142, 0xA, false); WSF_STEP(0x143, 0xC, false);
#undef WSF_STEP
    return x;
}
__device__ __forceinline__ void p2_post(const Prm& P, LAS unsigned char* lds, int vcu, int G, bool grp) {
    const int tid = opaque_tid(), lane = tid & 63, wave = tid >> 6;
    unsigned char* ws = P.ws;
    if (grp ? (vcu & 31) < 16 : vcu < NB * 8) {
        const int b = grp ? 2 * (vcu >> 5) + ((vcu & 31) >> 3) : vcu >> 3, h = vcu & 7;
        const float* FLG = (const float*)(ws + WS_FLG) + (size_t)b * SEQ * 8 + h; float* FL = (float*)(ws + WS_FL) + ((size_t)b * 8 + h) * SEQ;
        const float bf = P.b_forget[h];
        LAS float* part = (LAS float*)lds;
        float vals[8];
#pragma unroll
        for (int i = 0; i < 8; ++i) vals[i] = FLG[(size_t)(512 * wave + 64 * i + lane) * 8];
        float carry = 0.f;
#pragma unroll
        for (int i = 0; i < 8; ++i) { vals[i] = carry + wave_incl_scan_f(LOG2E * log_sigmoid(vals[i] + bf)); carry = __builtin_bit_cast(float, __builtin_amdgcn_readlane(__builtin_bit_cast(int, vals[i]), 63)); }
        if (lane == 0) part[wave] = carry;
        __syncthreads();
        float off = 0.f;
#pragma unroll
        for (int w = 0; w < 7; ++w) off += w < wave ? part[w] : 0.f;
#pragma unroll
        for (int i = 0; i < 8; ++i) FL[512 * wave + 64 * i + lane] = -(off + vals[i]);
    }
    const int gw = vcu * NWAVES + wave, NGW = G * NWAVES;
    const int rb = grp ? 8192 * (vcu >> 5) : 0, Ml = grp ? 8192 : M, gwl = grp ? (vcu & 31) * NWAVES + wave : gw, NGl = grp ? 32 * NWAVES : NGW;
    bf16* QQ = (bf16*)(ws + WS_QQ); bf16* KK = (bf16*)(ws + WS_KK); bf16* IQ = (bf16*)(ws + WS_IQ); bf16* IK = (bf16*)(ws + WS_IK);
    const float* IKRAW = (const float*)(ws + WS_IKRAW); float* IW = (float*)(ws + WS_IW);
    const float* COS = (const float*)(ws + WS_COS); const float* SIN = (const float*)(ws + WS_SIN);
    const float ikg = P.ikg[lane], ikb = P.ikb[lane];
    {
      unsigned* KMAX = (unsigned*)(ws + WS_CTL) + CW_KMAX; const int head = lane >> 3, part = lane & 7;
      for (int ml0 = gwl * 32; ml0 < Ml; ml0 += NGl * 32) { const int m0 = rb + ml0; float mx = 0.f;
        _Pragma("unroll 1") for (int k0 = 0; k0 < 32; k0 += 16) { u32x4 vv[16];
#pragma unroll
          for (int k = 0; k < 16; ++k) vv[k] = *(const u32x4*)(KK + (size_t)(m0 + k0 + k) * 1024 + head * 64 + part * 8);
#pragma unroll
          for (int k = 0; k < 16; ++k) { const u32x4 v = vv[k]; float sq = 0.f;
#pragma unroll
            for (int i = 0; i < 4; ++i) { const float a = bf2f(v[i] & 0xFFFFu), c2 = bf2f(v[i] >> 16); sq += a * a + c2 * c2; }
            sq += __shfl_xor(sq, 1); sq += __shfl_xor(sq, 2); sq += __shfl_xor(sq, 4); mx = fmaxf(mx, sq); } }
        if (part == 0) atomicMax(&KMAX[(m0 >> 12) * 8 + head], __float_as_uint(mx)); } }
    for (int ml16 = gwl * 32; ml16 < Ml; ml16 += NGl * 32) { const int m16 = rb + ml16;
        const int head = (lane >> 1) & 7, half = lane & 1;
        f32x4 c4[8], s4[8]; u32x2 a[8], b2[8];
#pragma unroll
        for (int i = 0; i < 8; ++i) { const int m = m16 + 4 * i + (lane >> 4); const bf16* p = KK + (size_t)m * 1024 + 512 + head * 64 + 4 * half;
            c4[i] = *(const f32x4*)(COS + (size_t)m * 8 + 4 * half); s4[i] = *(const f32x4*)(SIN + (size_t)m * 8 + 4 * half); a[i] = *(const u32x2*)p; b2[i] = *(const u32x2*)(p + 8); }
#pragma unroll
        for (int i = 0; i < 8; ++i) { const int m = m16 + 4 * i + (lane >> 4); bf16* p = KK + (size_t)m * 1024 + 512 + head * 64 + 4 * half;
            const f32x4 t1 = {bf2f(a[i].x & 0xFFFFu), bf2f(a[i].x >> 16), bf2f(a[i].y & 0xFFFFu), bf2f(a[i].y >> 16)}, t2 = {bf2f(b2[i].x & 0xFFFFu), bf2f(b2[i].x >> 16), bf2f(b2[i].y & 0xFFFFu), bf2f(b2[i].y >> 16)};
            const f32x4 o1 = t1 * c4[i] - t2 * s4[i], o2 = t2 * c4[i] + t1 * s4[i];
            *(u32x2*)p = (u32x2){pk2(o1[0], o1[1]), pk2(o1[2], o1[3])}; *(u32x2*)(p + 8) = (u32x2){pk2(o2[0], o2[1]), pk2(o2[2], o2[3])}; }
    }
    for (int mm = gwl; mm < Ml; mm += 8 * NGl) {
        int mr[8]; float c[8], s[8], v[8];
#pragma unroll
        for (int i = 0; i < 8; ++i) { mr[i] = rb + (mm + i * NGl < Ml ? mm + i * NGl : mm); c[i] = COS[(size_t)mr[i] * 8 + (lane & 7)]; s[i] = SIN[(size_t)mr[i] * 8 + (lane & 7)]; v[i] = IKRAW[(size_t)mr[i] * 64 + lane]; }
#pragma unroll
        for (int i = 0; i < 8; ++i) {
            const float mean = wave_sum(v[i]) * (1.f / 64.f); const float xc = v[i] - mean;
            const float var = wave_sum(xc * xc) * (1.f / 64.f);
            float y = xc * (1.0f / sqrtf(var + LN_EPS)) * ikg + ikb;
            const float other = __shfl_xor(y, 8);
            if (lane < 8) y = y * c[i] - other * s[i]; else if (lane < 16) y = y * c[i] + other * s[i];
            IK[(size_t)mr[i] * 64 + lane] = (bf16)f2bf(y); }
    }
}

constexpr int IX_HIST = 0, IX_IQS = 65536, IX_IQ_PITCH = 1040, IX_SELB = IX_IQS + 32 * IX_IQ_PITCH, IX_CB = IX_SELB + 16384, IX_CC = IX_CB + 16384, IX_INFO = IX_CC + 8192;
constexpr int IX_WQ = IX_INFO + 512, IX_STG2 = IX_WQ + 1024;
constexpr int IX_LIST = IX_HIST, IX_CNT = IX_CC, IX_CAP = 512, IX_RH = IX_CB;
static_assert(IX_STG2 + 16384 <= MISC_OFF, "indexer LDS map");
__device__ __forceinline__ unsigned ordered_key(float f) { const unsigned u = __builtin_bit_cast(unsigned, f); return u ^ ((u >> 31) ? 0xFFFFFFFFu : 0x80000000u); }
__device__ __forceinline__ int win_bin(float f) {
    const unsigned u = __builtin_bit_cast(unsigned, f); const int a = (int)(u & 0x7FFFFFFFu);
    int m = (a - 0x3A800000 + (1 << 18)) >> 18; m = m < 0 ? 0 : m > 481 ? 481 : m;
    return (m ^ ((int)u >> 31)) + 512;
}
__device__ __forceinline__ int wave_incl_scan(int x) {
    x += __builtin_amdgcn_update_dpp(0, x, 0x111, 0xF, 0xF, true);
    x += __builtin_amdgcn_update_dpp(0, x, 0x112, 0xF, 0xF, true);
    x += __builtin_amdgcn_update_dpp(0, x, 0x114, 0xF, 0xF, true);
    x += __builtin_amdgcn_update_dpp(0, x, 0x118, 0xF, 0xF, true);
    x += __builtin_amdgcn_update_dpp(0, x, 0x142, 0xA, 0xF, false);
    x += __builtin_amdgcn_update_dpp(0, x, 0x143, 0xC, 0xF, false);
    return x;
}
__device__ __forceinline__ void find_bucket2(const LAS unsigned* hrow, int needA, int needB, int lane, int& binA, int& binB) {
    const int lr = 63 - lane;
    unsigned w[8];
#pragma unroll
    for (int j = 0; j < 8; ++j) w[j] = hrow[8 * lr + j];
    int tot = 0;
#pragma unroll
    for (int j = 0; j < 8; ++j) tot += (int)(w[j] & 0xFFFFu) + (int)(w[j] >> 16);
    const int S = wave_incl_scan(tot) - tot;
    int ba = -1, bb = -1;
    if (S < needB && S + tot >= needA) {
        int acc = S;
#pragma unroll
        for (int i = 15; i >= 0; --i) { const int cnt = (i & 1) ? (int)(w[i >> 1] >> 16) : (int)(w[i >> 1] & 0xFFFFu);
            if (acc < needA && acc + cnt >= needA) ba = 16 * lr + i;
            if (acc < needB && acc + cnt >= needB) bb = 16 * lr + i;
            acc += cnt; }
    }
    const unsigned long long balA = __ballot(ba >= 0), balB = __ballot(bb >= 0);
    binA = __builtin_amdgcn_readlane(ba, balA ? (int)__builtin_ctzll(balA) : 0); binB = __builtin_amdgcn_readlane(bb, balB ? (int)__builtin_ctzll(balB) : 0);
}
__device__ __forceinline__ void find_bucket(const LAS unsigned* hrow, int need, int lane, int& bin_out, int& above_out) {
    const int lr = 63 - lane;
    unsigned w[8];
#pragma unroll
    for (int j = 0; j < 8; ++j) w[j] = hrow[8 * lr + j];
    int tot = 0;
#pragma unroll
    for (int j = 0; j < 8; ++j) tot += (int)(w[j] & 0xFFFFu) + (int)(w[j] >> 16);
    const int S = wave_incl_scan(tot) - tot;
    int bin = -1, above = 0;
    if (S < need && S + tot >= need) {
        int acc = S; bool done = false;
#pragma unroll
        for (int i = 15; i >= 0; --i) { const int cnt = (i & 1) ? (int)(w[i >> 1] >> 16) : (int)(w[i >> 1] & 0xFFFFu);
            if (!done) { if (acc + cnt >= need) { bin = 16 * lr + i; above = acc; done = true; } else acc += cnt; } }
    }
    const unsigned long long bal = __ballot(bin >= 0);
    const int src = bal ? (int)__builtin_ctzll(bal) : 0;
    bin_out = __builtin_amdgcn_readlane(bin, src); above_out = __builtin_amdgcn_readlane(above, src);
}
#ifndef IX_UNROLL
#define IX_UNROLL 4
#endif
__device__ __forceinline__ float relu_s(float x) { const int i = __builtin_bit_cast(int, x); return __builtin_bit_cast(float, i > 0 ? i : 0); }
template <bool HALF>
__device__ __forceinline__ void ix_scores(f32x16& sc0, f32x16& sc1, const bf16x8 (&kf)[4][2], const LAS unsigned char* iqrow, const LAS float* wq) {
    sc0 = f32x16{}; sc1 = f32x16{};
#pragma unroll IX_UNROLL
    for (int h = 0; h < 8; ++h) {
        const float wqh = wq[h];
        bf16x8 qf[4];
#pragma unroll
        for (int d0 = 0; d0 < 4; ++d0) qf[d0] = *(const LAS bf16x8*)(iqrow + (h * 4 + d0) * 1024);
        f32x16 x0 = f32x16{}, x1 = f32x16{};
#pragma unroll
        for (int d0 = 0; d0 < 4; ++d0) { x0 = __builtin_amdgcn_mfma_f32_32x32x16_bf16(kf[d0][0], qf[d0], x0, 0, 0, 0);
            if (!HALF) x1 = __builtin_amdgcn_mfma_f32_32x32x16_bf16(kf[d0][1], qf[d0], x1, 0, 0, 0); }
#pragma unroll
        for (int r = 0; r < 16; ++r) { const float rx = relu_s(x0[r]); asm("v_fmac_f32_e32 %0, %1, %2" : "+v"(sc0[r]) : "v"(wqh), "v"(rx)); }
        if (!HALF) {
#pragma unroll
            for (int r = 0; r < 16; ++r) { const float rx = relu_s(x1[r]); asm("v_fmac_f32_e32 %0, %1, %2" : "+v"(sc1[r]) : "v"(wqh), "v"(rx)); }
        }
    }
}
__device__ __forceinline__ unsigned bin_key_lo(int b) {
    if (b <= 30) return 0u;
    if (b >= 994) return 0xFFFFFFFFu;
    if (b >= 512) { const int m = b - 512; return 0x80000000u + (m == 0 ? 0u : 0x3A800000u + ((unsigned)(m - 1) << 18)); }
    return 0x80000000u - (0x3A800000u + ((unsigned)(511 - b) << 18));
}
__device__ __forceinline__ unsigned key_to_float_bits(unsigned k) {
    if (k == 0u) return 0xFF800000u;
    if (k == 0xFFFFFFFFu) return 0x7F800000u;
    return k ^ ((k >> 31) ? 0x80000000u : 0xFFFFFFFFu);
}
template <bool HALF>
__device__ __forceinline__ void ix_load_k(bf16x8 (&kf)[4][2], const bf16* IK, int b, int row0, int stride, int r32, int hi) {
    const bf16* kp = IK + (size_t)(b * SEQ + row0 + stride * r32) * 64 + 8 * hi;
#pragma unroll
    for (int d0 = 0; d0 < 4; ++d0) { kf[d0][0] = *(const bf16x8*)(kp + 16 * d0); kf[d0][1] = HALF ? kf[d0][0] : *(const bf16x8*)(kp + 32 * 64 + 16 * d0); }
}
template <int MODE>
__device__ __forceinline__ void ix_first_k(bf16x8 (&kf)[4][2], const bf16* IK, int b, int c, int tid) {
    const int lane = tid & 63, t = tid >> 6, r32_ = lane & 31, hi_ = lane >> 5;
    const int nit = MODE == 5 ? (c + 2) >> 1 : c + 1;
    const bool pair = MODE == 5 && 2 * t + 1 <= c;
    if (t < nit) ix_load_k<MODE == 5>(kf, IK, b, MODE == 5 ? 128 * t + (pair ? (t & 3) : 0) : 64 * t, pair ? 4 : 1, r32_, hi_);
}
template <int MODE, bool PRE = false>
__device__ __forceinline__ void ix_pass(LAS unsigned char* lds, const bf16* IK, int b, int c, int tid, bf16x8 (&kf)[4][2]) {
    const int lane = tid & 63, wave = tid >> 6, r32_ = lane & 31, hi_ = lane >> 5;
    LAS unsigned* hist = (LAS unsigned*)(lds + IX_HIST);
    LAS unsigned long long* selb = (LAS unsigned long long*)(lds + IX_SELB);
    LAS unsigned long long* cb = (LAS unsigned long long*)(lds + IX_CB);
    LAS int* cc = (LAS int*)(lds + IX_CC);
    LAS int* info = (LAS int*)(lds + IX_INFO);
    LAS unsigned* list = (LAS unsigned*)(lds + IX_LIST); LAS int* cnt = (LAS int*)(lds + IX_CNT);
    const LAS unsigned char* iqrow = lds + IX_IQS + (hi_ * 32 + r32_) * 16;
    const LAS float* wqp = (const LAS float*)(lds + IX_WQ) + r32_ * 8;
    const int rb = info[r32_];
    const int rc = info[32 + r32_];
    const int t20 = info[64 + r32_];
    const int nit = MODE == 5 ? (c + 2) >> 1 : c + 1;
    for (int t = wave; t < nit; t += NWAVES) {
        f32x16 sc0, sc1;
        const bool pair = MODE == 5 && 2 * t + 1 <= c;
        { if (!PRE || t != wave) ix_load_k<MODE == 5>(kf, IK, b, MODE == 5 ? 128 * t + (pair ? (t & 3) : 0) : 64 * t, pair ? 4 : 1, r32_, hi_);
          ix_scores<MODE == 5>(sc0, sc1, kf, iqrow, wqp); }
        unsigned sw0 = 0u, sw1 = 0u, cw0 = 0u, cw1 = 0u;
        int r32 = r32_, hi = hi_; asm volatile("" : "+v"(r32), "+v"(hi));
        if (MODE == 6) {
            const float fsel = __int_as_float(rb), fcand = __int_as_float(rc);
            unsigned a0 = 0u, a1 = 0u, b0 = 0u, b1 = 0u;
#pragma unroll
            for (int r = 15; r >= 0; --r) {
                a0 = __builtin_amdgcn_alignbit(a0, __float_as_uint(sc0[r] - fsel), 31); a1 = __builtin_amdgcn_alignbit(a1, __float_as_uint(sc1[r] - fsel), 31);
                b0 = __builtin_amdgcn_alignbit(b0, __float_as_uint(sc0[r] - fcand), 31); b1 = __builtin_amdgcn_alignbit(b1, __float_as_uint(sc1[r] - fcand), 31);
            }
#define IX_SPREAD(x) ({ unsigned y_ = (~(x)) & 0xFFFFu; y_ = (y_ | (y_ << 8)) & 0x00FF00FFu; (y_ | (y_ << 4)) & 0x0F0F0F0Fu; })
            sw0 = IX_SPREAD(a0); sw1 = IX_SPREAD(a1); cw0 = IX_SPREAD(b0) & ~sw0; cw1 = IX_SPREAD(b1) & ~sw1;
#undef IX_SPREAD
        }
#pragma unroll
        for (int r = 0; r < 16; ++r) {
            if (MODE == 6) break;
#pragma unroll
            for (int hh = 0; hh < 2; ++hh) {
                const float sc = hh ? sc1[r] : sc0[r];
                const int cp = (r & 3) + 8 * (r >> 2);
                if (MODE == 5) { if (hh == 0 && ((r & 1) == 0 || pair)) { const unsigned bin = (unsigned)win_bin(sc); atomicAdd((unsigned*)&hist[r32 * 512 + (bin >> 1)], 1u << (16 * (bin & 1))); } }
                if (MODE == 1) { const unsigned bin = ordered_key(sc) >> 22; atomicAdd((unsigned*)&hist[r32 * 512 + (bin >> 1)], 1u << (16 * (bin & 1))); }
                if (MODE == 2) { const unsigned k = ordered_key(sc); if ((int)(k >> 22) == rb) { const unsigned bin = (k >> 12) & 1023u; atomicAdd((unsigned*)&hist[r32 * 512 + (bin >> 1)], 1u << (16 * (bin & 1))); } }
                if (MODE == 4) { const int pf = (int)(ordered_key(sc) >> 12); const unsigned s = pf > t20 ? 1u : 0u, cnd = pf == t20 ? 1u : 0u;
                    if (hh) { sw1 |= s << cp; cw1 |= cnd << cp; } else { sw0 |= s << cp; cw0 |= cnd << cp; } }
            }
            __builtin_amdgcn_sched_barrier(0);
        }
        if (MODE == 6) {
            int base = 0;
            { const int nc = __popc(cw0) + __popc(cw1);
              if (nc > 0) { base = atomicAdd((int*)&cnt[r32], nc); if (base + nc > IX_CAP) { cnt[32] = 1; cw0 = 0u; cw1 = 0u; } } }
            LAS float* stg = (LAS float*)(lds + (wave < 4 ? IX_CB + wave * 4096 : IX_STG2 + (wave - 4) * 4096)) + lane;
            LAS unsigned* lp = list + r32 * IX_CAP + base;
#pragma unroll
            for (int hh = 0; hh < 2; ++hh) {
#pragma unroll
                for (int r = 0; r < 16; ++r) stg[64 * r] = hh ? sc1[r] : sc0[r];
                unsigned w = hh ? cw1 : cw0;
                const int kb = 4095 - (64 * t + 4 * hi + 32 * hh);
                while (w != 0u) { const int cp = (int)__builtin_ctz(w); w &= w - 1u;
                    const float s = stg[64 * ((cp & 3) | ((cp >> 1) & 12))];
                    *lp++ = (ordered_key(s) & 0xFFFFF000u) | (unsigned)(kb - cp); }
            }
        }
        if (MODE == 4 || MODE == 6) {
            sw0 <<= 4 * hi; sw1 <<= 4 * hi; sw0 |= __shfl_xor(sw0, 32); sw1 |= __shfl_xor(sw1, 32);
            if (MODE == 4) { cw0 <<= 4 * hi; cw1 <<= 4 * hi; cw0 |= __shfl_xor(cw0, 32); cw1 |= __shfl_xor(cw1, 32); }
            if (hi == 0) { selb[r32 * 64 + t] = ((unsigned long long)sw1 << 32) | sw0;
                if (MODE == 4) { cb[r32 * 64 + t] = ((unsigned long long)cw1 << 32) | cw0; cc[r32 * 64 + t] = __popc(cw0) + __popc(cw1); } }
        }
    }
}
__device__ __forceinline__ void p3_indexer(const Prm& P, LAS unsigned char* lds, int vcu, int G, bool grp) {
    const int tid0 = threadIdx.x;
    unsigned char* ws = P.ws;
    const bf16* IQ = (const bf16*)(ws + WS_IQ); const bf16* IK = (const bf16*)(ws + WS_IK); const float* IW = (const float*)(ws + WS_IW);
    unsigned* MASK = (unsigned*)(ws + WS_MASK);
    LAS unsigned* hist = (LAS unsigned*)(lds + IX_HIST);
    LAS unsigned long long* selb = (LAS unsigned long long*)(lds + IX_SELB);
    LAS unsigned long long* cb = (LAS unsigned long long*)(lds + IX_CB);
    LAS int* cc = (LAS int*)(lds + IX_CC);
    LAS int* info = (LAS int*)(lds + IX_INFO);
    LAS unsigned* list = (LAS unsigned*)(lds + IX_LIST); LAS int* cnt = (LAS int*)(lds + IX_CNT);
    const int NUN = NB * 64 * 2;
#define IX_TID(name) int name; { int z_ = 0; asm volatile("" : "+s"(z_)); name = tid0 + z_; }
#define IX_CLEAR_HIST() do { IX_TID(t_); for (int i = t_; i < 32 * 512; i += NTHR) hist[i] = 0u; } while (0)
#define IX_BUCKETS(FAST, SECOND) do { IX_TID(t_); const int lane_ = t_ & 63, wave_ = t_ >> 6; \
        _Pragma("unroll 1") for (int k = 0; k < 4; ++k) { const int row = wave_ * 4 + k; const int need = (SECOND) ? info[32 + row] : TOPK; int bin, above; find_bucket(hist + row * 512, need, lane_, bin, above); \
            if (lane_ == 0) { if (SECOND) { info[64 + row] = (info[row] << 10) | bin; info[96 + row] = need - above; } else { info[row] = bin; info[32 + row] = need - above; \
                if ((FAST) && (bin <= 30 || bin == 511 || bin == 512 || bin >= 993)) cnt[32] = 1; } } } } while (0)
    for (int u0 = vcu; u0 < NUN; u0 += G) {
        int b, c, half;
        if (grp) { const int s = (vcu & 31) + 32 * (u0 >> 8);
            c = 63 - (s >> 2); b = 2 * (vcu >> 5) + ((s >> 1) & 1); half = s & 1; }
        else { const int u = NUN - 1 - u0; b = u & 15; const int rem = u >> 4; c = rem >> 1; half = rem & 1; }
        const int m0 = b * SEQ + 64 * c + 32 * half;
        if (c < 4) {
            for (int i = tid0; i < 32 * 2 * (c + 1); i += NTHR) { const int q = i / (2 * (c + 1)), w = i % (2 * (c + 1)); MASK[(size_t)(m0 + q) * 128 + w] = 0xFFFFFFFFu; }
            continue;
        }
        __syncthreads();
        DIAG_T0(P);
        bf16x8 kfp[4][2];
        { IX_TID(t_); ix_first_k<5>(kfp, IK, b, c, t_); }
        { IX_TID(t_);
          const int row = t_ & 31, chb = t_ >> 5;
          u32x4 own[4];
#pragma unroll
          for (int k = 0; k < 4; ++k) own[k] = *(const u32x4*)(IQ + (size_t)(m0 + row) * 512 + (chb + 16 * k) * 8);
          if ((chb & 7) < 2) {
              const float* cp = (const float*)(ws + WS_COS) + (size_t)(m0 + row) * 8; const float* sp = (const float*)(ws + WS_SIN) + (size_t)(m0 + row) * 8;
              const f32x4 c0 = *(const f32x4*)cp, c1 = *(const f32x4*)(cp + 4), s0 = *(const f32x4*)sp, s1 = *(const f32x4*)(sp + 4);
              const float sg = (chb & 1) ? 1.f : -1.f;
#pragma unroll
              for (int k = 0; k < 4; ++k) { u32x4 oth;
#pragma unroll
                for (int i = 0; i < 4; ++i) oth[i] = __shfl_xor(own[k][i], 32);
#pragma unroll
                for (int i = 0; i < 4; ++i) { const float cA = i < 2 ? c0[2 * i] : c1[2 * i - 4], cB = i < 2 ? c0[2 * i + 1] : c1[2 * i - 3], sA = i < 2 ? s0[2 * i] : s1[2 * i - 4], sB = i < 2 ? s0[2 * i + 1] : s1[2 * i - 3];
                    const float a = bf2f(own[k][i] & 0xFFFFu) * cA + sg * bf2f(oth[i] & 0xFFFFu) * sA, b2 = bf2f(own[k][i] >> 16) * cB + sg * bf2f(oth[i] >> 16) * sB; own[k][i] = pk2(a, b2); } }
          }
#pragma unroll
          for (int k = 0; k < 4; ++k) *(LAS u32x4*)(lds + IX_IQS + ((chb + 16 * k) * 32 + row) * 16) = own[k];
          if (t_ < 256) ((LAS float*)(lds + IX_WQ))[t_] = IW[(size_t)m0 * 8 + t_];
          if (t_ < 64) cnt[t_] = 0; }
        IX_CLEAR_HIST();
        __syncthreads();
        DIAG_ACC(P, 0);
#if defined(IX_SELFTEST)
        bool fast_ok = (u0 % 509) != 0;
#else
        bool fast_ok = true;
#endif
        if (fast_ok) {
            { IX_TID(t_); ix_pass<5, true>(lds, IK, b, c, t_, kfp); }
            { IX_TID(t_); ix_first_k<6>(kfp, IK, b, c, t_); }
            __syncthreads();
            DIAG_ACC(P, 1);
            { IX_TID(t_); const int lane_ = t_ & 63, wave_ = t_ >> 6; const int ns = 16 * (c + 1);
              _Pragma("unroll 1") for (int k = 0; k < 4; ++k) { const int row = wave_ * 4 + k; int bhi, blo, ab;
                if (100 < ns) find_bucket2(hist + row * 512, 28, 100, lane_, bhi, blo); else { find_bucket(hist + row * 512, 28, lane_, bhi, ab); blo = 0; }
                if (lane_ == 0) { info[row] = (int)key_to_float_bits(bin_key_lo(bhi + 1)); info[32 + row] = (int)key_to_float_bits(100 < ns ? bin_key_lo(blo) : 0u); } } }
            __syncthreads();
            DIAG_ACC(P, 2);
            { IX_TID(t_); ix_pass<6, true>(lds, IK, b, c, t_, kfp); }
            __syncthreads();
            DIAG_ACC(P, 3);
            { IX_TID(t_); const int lane_ = t_ & 63, wave_ = t_ >> 6; LAS unsigned* selw = (LAS unsigned*)selb;
              _Pragma("unroll 1") for (int k = 0; k < 4; k += 2) {
                unsigned v[2][8]; unsigned T[2]; int need[2]; bool same[2];
#pragma unroll
                for (int i = 0; i < 2; ++i) { const int row = wave_ * 4 + k + i;
                    int above = lane_ <= c ? __popcll(selb[row * 64 + lane_]) : 0;
                    above = __builtin_amdgcn_readlane(wave_incl_scan(above), 63);
                    int n = cnt[row]; need[i] = TOPK - above;
                    if (need[i] < 1 || need[i] > n || n > IX_CAP) { if (lane_ == 0) cnt[32] = 1; n = 0; need[i] = 1; }
#pragma unroll
                    for (int j = 0; j < 8; ++j) v[i][j] = (lane_ + 64 * j) < n ? list[row * IX_CAP + lane_ + 64 * j] : 0u;
                    T[i] = (unsigned)__builtin_amdgcn_readfirstlane((int)v[i][0]) & 0xFF000000u;
                    bool diff = false;
#pragma unroll
                    for (int j = 0; j < 8; ++j) diff |= v[i][j] != 0u && ((v[i][j] ^ T[i]) >> 24) != 0u;
                    same[i] = __ballot(diff) == 0ull; }
                const bool skip0 = same[0] && same[1];
                if (!skip0) { T[0] = 0u; T[1] = 0u; }
                LAS unsigned* rh = (LAS unsigned*)(lds + IX_RH) + wave_ * 512;
#pragma unroll
                for (int step = 0; step < 4; ++step) { const int shift = 24 - 8 * step;
                    if (step == 0 && skip0) continue;
                    const int lr = 63 - lane_;
                    u32x4 hh[2];
#pragma unroll
                    for (int i = 0; i < 2; ++i) *(LAS u32x4*)(rh + 256 * i + 4 * lane_) = (u32x4){0u, 0u, 0u, 0u};
#pragma unroll
                    for (int i = 0; i < 2; ++i) {
#pragma unroll
                        for (int j = 0; j < 8; ++j) { const unsigned x = v[i][j];
                            const bool act = x != 0u && (step == 0 || ((x ^ T[i]) >> (shift + 8 < 32 ? shift + 8 : 31)) == 0u);
                            if (act) atomicAdd((unsigned*)&rh[256 * i + ((x >> shift) & 255u)], 1u); } }
#pragma unroll
                    for (int i = 0; i < 2; ++i) hh[i] = *(const LAS u32x4*)(rh + 256 * i + 4 * lr);
#pragma unroll
                    for (int i = 0; i < 2; ++i) {
                        const int tot = (int)(hh[i][0] + hh[i][1] + hh[i][2] + hh[i][3]);
                        const int incl = wave_incl_scan(tot), excl = incl - tot, nd = need[i];
                        int bin = -1, ab = 0;
                        if (excl < nd && incl >= nd) {
                            int acc = excl;
                            if (acc + (int)hh[i][3] >= nd) { bin = 3; ab = acc; } else { acc += (int)hh[i][3];
                            if (acc + (int)hh[i][2] >= nd) { bin = 2; ab = acc; } else { acc += (int)hh[i][2];
                            if (acc + (int)hh[i][1] >= nd) { bin = 1; ab = acc; } else { acc += (int)hh[i][1]; bin = 0; ab = acc; } } }
                            bin += 4 * lr; }
                        const unsigned long long bal = __ballot(bin >= 0);
                        const int src = bal ? (int)__builtin_ctzll(bal) : 0;
                        bin = __builtin_amdgcn_readlane(bin, src); ab = __builtin_amdgcn_readlane(ab, src);
                        T[i] |= (unsigned)bin << shift; need[i] -= ab; } }
#pragma unroll
                for (int i = 0; i < 2; ++i) { const int row = wave_ * 4 + k + i;
#pragma unroll
                    for (int j = 0; j < 8; ++j) if (v[i][j] >= T[i] && v[i][j] != 0u) { const int idx = 4095 - (int)(v[i][j] & 4095u); atomicOr((unsigned*)&selw[row * 128 + (idx >> 5)], 1u << (idx & 31)); } }
              } }
            __syncthreads();
            DIAG_ACC(P, 4);
            fast_ok = cnt[32] == 0;
            if (fast_ok) {
                IX_TID(t_);
                _Pragma("unroll 1") for (int k = 0; k < 4; ++k) { const int id = t_ + NTHR * k, q = id >> 6, t = id & 63;
                    if (t <= c) { const unsigned long long outw = selb[q * 64 + t]; *(u32x2*)(MASK + (size_t)(m0 + q) * 128 + 2 * t) = (u32x2){(unsigned)outw, (unsigned)(outw >> 32)}; } }
            }
        }
        DIAG_ACC(P, 5);
        if (fast_ok) continue;
        __syncthreads();
        IX_CLEAR_HIST();
        __syncthreads();
        { IX_TID(t_); ix_pass<1>(lds, IK, b, c, t_, kfp); }
        __syncthreads();
        IX_BUCKETS(false, false);
        __syncthreads();
        IX_CLEAR_HIST();
        __syncthreads();
        { IX_TID(t_); ix_pass<2>(lds, IK, b, c, t_, kfp); }
        __syncthreads();
        IX_BUCKETS(false, true);
        __syncthreads();
        { IX_TID(t_); ix_pass<4>(lds, IK, b, c, t_, kfp); }
        __syncthreads();
        { IX_TID(t_);
          if (t_ < 32) { int run = info[96 + t_];
            for (int t = 0; t <= c; ++t) { const int n = cc[t_ * 64 + t]; const int take = run < n ? run : n; cc[t_ * 64 + t] = take; run -= take; } } }
        __syncthreads();
        { IX_TID(t_);
          _Pragma("unroll 1") for (int k = 0; k < 4; ++k) { const int id = t_ + NTHR * k, q = id >> 6, t = id & 63;
            if (t <= c) { int take = cc[q * 64 + t]; unsigned long long cbw = cb[q * 64 + t], outw = selb[q * 64 + t];
                while (take > 0) { const unsigned long long low = cbw & (0ull - cbw); outw |= low; cbw ^= low; --take; }
                *(u32x2*)(MASK + (size_t)(m0 + q) * 128 + 2 * t) = (u32x2){(unsigned)outw, (unsigned)(outw >> 32)}; } } }
        DIAG_ACC(P, 6);
    }
#undef IX_TID
#undef IX_CLEAR_HIST
#undef IX_BUCKETS
}

namespace af {
typedef float f32x2_t __attribute__((ext_vector_type(2))); typedef __bf16 bf16x2_t __attribute__((ext_vector_type(2)));
constexpr int NW = 8, QBLK = 32, QB = 256, KVBLK = 64, DMP = 1024;
constexpr int NSLOT = 3, SLOTB = 8192;
constexpr int LDS_K = 0, LDS_V = NSLOT * SLOTB, LDS_WS = 2 * NSLOT * SLOTB, LDS_OST = LDS_WS + NW * 64 * 4, LDS_END = LDS_OST + NW * 4096;
constexpr int LDS_BIAS = LDS_END;
static_assert(LDS_BIAS + 16384 <= MISC_OFF, "attention LDS map");
constexpr int LDS_VOTE = LDS_BIAS + 16384;
static_assert(LDS_VOTE + 64 <= MISC_OFF, "attention LDS map");
constexpr float FLOOR = -1000.0f;
#define SBAR() __builtin_amdgcn_sched_barrier(0)
__device__ __forceinline__ void glds16(const void* gsrc, unsigned lds_dst) { unsigned keep;
  asm volatile("s_mov_b32 %0, m0\n\ts_mov_b32 m0, %2\n\ts_nop 0\n\tglobal_load_lds_dwordx4 %1, off\n\ts_mov_b32 m0, %0" : "=&s"(keep) : "v"(gsrc), "s"(lds_dst) : "memory"); }
__device__ __forceinline__ void glds4(const void* gsrc, unsigned lds_dst) { unsigned keep;
  asm volatile("s_mov_b32 %0, m0\n\ts_mov_b32 m0, %2\n\ts_nop 0\n\tglobal_load_lds_dword %1, off\n\ts_mov_b32 m0, %0" : "=&s"(keep) : "v"(gsrc), "s"(lds_dst) : "memory"); }
__device__ __forceinline__ void glds16s(const void* sbase, unsigned voff, unsigned lds_dst) { unsigned keep;
  asm volatile("s_mov_b32 %0, m0\n\ts_mov_b32 m0, %3\n\ts_nop 0\n\tglobal_load_lds_dwordx4 %1, %2\n\ts_mov_b32 m0, %0" : "=&s"(keep) : "v"(voff), "s"(sbase), "s"(lds_dst) : "memory"); }
__device__ __forceinline__ void glds4s(const void* sbase, unsigned voff, unsigned lds_dst) { unsigned keep;
  asm volatile("s_mov_b32 %0, m0\n\ts_mov_b32 m0, %3\n\ts_nop 0\n\tglobal_load_lds_dword %1, %2\n\ts_mov_b32 m0, %0" : "=&s"(keep) : "v"(voff), "s"(sbase), "s"(lds_dst) : "memory"); }
__device__ __forceinline__ float max3f(float a, float b, float c) { float r; asm("v_max3_f32 %0, %1, %2, %3" : "=v"(r) : "v"(a), "v"(b), "v"(c)); return r; }
__device__ __forceinline__ float max2f(float a, float b) { float r; asm("v_max_f32_e32 %0, %1, %2" : "=v"(r) : "v"(a), "v"(b)); return r; }
__device__ __forceinline__ float fadd_s(float a, float b) { float r; asm("v_add_f32_e32 %0, %1, %2" : "=v"(r) : "v"(a), "v"(b)); return r; }
__device__ __forceinline__ float fsub_s(float a, float b) { float r; asm("v_sub_f32_e32 %0, %1, %2" : "=v"(r) : "v"(a), "v"(b)); return r; }
__device__ __forceinline__ unsigned cvtpk_s(float lo, float hi) { f32x2_t v = {lo, hi}; bf16x2_t b = __builtin_convertvector(v, bf16x2_t); return __builtin_bit_cast(unsigned, b); }
#define WAIT_BAR(N) asm volatile("s_waitcnt vmcnt(" #N ") lgkmcnt(0)\n\ts_barrier" ::: "memory")
template <bool FROM_P>
__device__ __forceinline__ void qkt(f32x16& p0, f32x16& p1, const char* Kslot, const bf16x8* qr, const f32x16& negm, int r32, int hi) {
  const char* kb = Kslot + hi * 1024 + r32 * 16;
#pragma unroll
  for (int d0 = 0; d0 < 4; ++d0) {
    const bf16x8 b0 = *reinterpret_cast<const bf16x8*>(kb + d0 * 2048);
    const bf16x8 b1 = *reinterpret_cast<const bf16x8*>(kb + d0 * 2048 + 512);
    if (d0 == 0 && !FROM_P) { p0 = __builtin_amdgcn_mfma_f32_32x32x16_bf16(b0, qr[0], negm, 0, 0, 0); p1 = __builtin_amdgcn_mfma_f32_32x32x16_bf16(b1, qr[0], negm, 0, 0, 0); }
    else { p0 = __builtin_amdgcn_mfma_f32_32x32x16_bf16(b0, qr[d0], p0, 0, 0, 0); p1 = __builtin_amdgcn_mfma_f32_32x32x16_bf16(b1, qr[d0], p1, 0, 0, 0); } }
}
typedef __attribute__((address_space(3))) const char* lds_cptr;
typedef short v4i16_t __attribute__((ext_vector_type(4)));
__device__ __forceinline__ void kload8(bf16x8* kf, lds_cptr kp) {
  kf[0] = *(const LAS bf16x8*)(kp);        kf[1] = *(const LAS bf16x8*)(kp + 512);
  kf[2] = *(const LAS bf16x8*)(kp + 2048); kf[3] = *(const LAS bf16x8*)(kp + 2560);
  kf[4] = *(const LAS bf16x8*)(kp + 4096); kf[5] = *(const LAS bf16x8*)(kp + 4608);
  kf[6] = *(const LAS bf16x8*)(kp + 6144); kf[7] = *(const LAS bf16x8*)(kp + 6656);
}
__device__ __forceinline__ void kload2(bf16x8* kf, lds_cptr kp, int j) { kf[2 * j] = *(const LAS bf16x8*)(kp + j * 2048); kf[2 * j + 1] = *(const LAS bf16x8*)(kp + j * 2048 + 512); }
__device__ __forceinline__ s16x4 vtr(lds_cptr p) { return __builtin_bit_cast(s16x4, __builtin_amdgcn_ds_read_tr16_b64_v4i16((LAS v4i16_t*)p)); }
__device__ __forceinline__ float rowmax(const f32x16& p0, const f32x16& p1) {
  float a = max3f(p0[0], p0[1], p1[0]), b = max3f(p0[2], p0[3], p1[1]); a = max3f(a, p1[2], p1[3]);
#pragma unroll
  for (int r = 4; r < 16; r += 4) { a = max3f(a, p0[r], p0[r + 1]); b = max3f(b, p0[r + 2], p0[r + 3]); a = max3f(a, p1[r], p1[r + 1]); b = max3f(b, p1[r + 2], p1[r + 3]); }
  const float m = max2f(a, b);
  auto rr = __builtin_amdgcn_permlane32_swap(__float_as_uint(m), __float_as_uint(m), false, false);
  return max2f(__uint_as_float(rr[0]), __uint_as_float(rr[1]));
}
__device__ __forceinline__ void pv(f32x16* o, int vb, bf16x8 pa0, bf16x8 pa1, bf16x8 pa2, bf16x8 pa3) {
#pragma unroll
  for (int d0 = 0; d0 < 2; ++d0) { s16x4 lo[4], hi[4];
#pragma unroll
    for (int ks = 0; ks < 4; ++ks) {
      asm volatile("ds_read_b64_tr_b16 %0,%1 offset:%c2" : "=&v"(lo[ks]) : "v"(vb), "i"(d0 * 4096 + ks * 1024) : "memory");
      asm volatile("ds_read_b64_tr_b16 %0,%1 offset:%c2" : "=&v"(hi[ks]) : "v"(vb), "i"(d0 * 4096 + ks * 1024 + 512) : "memory"); }
    asm volatile("s_waitcnt lgkmcnt(0)" ::: "memory"); SBAR();
#define PK(k) (bf16x8){lo[k][0], lo[k][1], lo[k][2], lo[k][3], hi[k][0], hi[k][1], hi[k][2], hi[k][3]}
    o[d0] = __builtin_amdgcn_mfma_f32_32x32x16_bf16(pa0, PK(0), o[d0], 0, 0, 0);
    o[d0] = __builtin_amdgcn_mfma_f32_32x32x16_bf16(pa1, PK(1), o[d0], 0, 0, 0);
    o[d0] = __builtin_amdgcn_mfma_f32_32x32x16_bf16(pa2, PK(2), o[d0], 0, 0, 0);
    o[d0] = __builtin_amdgcn_mfma_f32_32x32x16_bf16(pa3, PK(3), o[d0], 0, 0, 0);
#undef PK
  }
}
template <int MODE>
__device__ __forceinline__ void modify(f32x16& P0, f32x16& P1, int gt, int cw, int wid, int r32, int hi, const LAS float* bias, float mref) {
  const float NEG = -INFINITY;
  if (MODE == 0) {
    if (gt >= cw) { asm volatile("; diagonal / above-diagonal tile" ::: "memory");
      const int qin = gt > cw ? -1 : 32 * (wid & 1) + r32 - 4 * hi;
#pragma unroll
      for (int r = 0; r < 16; ++r) { const int kin = (r & 3) + 8 * (r >> 2); if (kin > qin) P0[r] = NEG; if (kin + 32 > qin) P1[r] = NEG; } }
  }
  if (MODE == 2) {
    const int dj = cw - gt;
    if (dj < 0 || dj > 8) {
#pragma unroll
      for (int r = 0; r < 16; ++r) { P0[r] = NEG; P1[r] = NEG; }
    } else if (dj <= 2) { const int qoff = 64 * dj + 32 * (wid & 1) + r32 + 128;
#pragma unroll
      for (int r = 0; r < 16; ++r) { int i0 = qoff - crow(r, hi), i1 = i0 - 32; i0 = i0 > 256 ? 256 : i0; i1 = i1 > 256 ? 256 : i1; P0[r] += bias[i0]; P1[r] += bias[i1]; } }
  }
}
__device__ __forceinline__ void bias_preload(f32x16& C0, f32x16& C1, const LAS float* bias, int gt, int hi) {
  const LAS float* fb = bias + 64 * gt + 4 * hi;
#pragma unroll
  for (int g = 0; g < 4; ++g) { const f32x4 a = *(const LAS f32x4*)(fb + 8 * g), b = *(const LAS f32x4*)(fb + 32 + 8 * g);
#pragma unroll
    for (int i = 0; i < 4; ++i) { C0[4 * g + i] = a[i]; C1[4 * g + i] = b[i]; } }
}
__device__ __forceinline__ void mask_preload(f32x16& C0, f32x16& C1, const LAS char* mw, bool above, float mref, int r32, int hi) {
  const u32x2 w = *(const LAS u32x2*)(mw + 8 * r32); const int w0 = above ? 0 : (int)(w.x >> (4 * hi)), w1 = above ? 0 : (int)(w.y >> (4 * hi));
  const unsigned nm = __float_as_uint(-mref);
#pragma unroll
  for (int r = 0; r < 16; ++r) { const int cp = (r & 3) + 8 * (r >> 2); const unsigned m0 = (unsigned)__builtin_amdgcn_sbfe(w0, cp, 1), m1 = (unsigned)__builtin_amdgcn_sbfe(w1, cp, 1);
    C0[r] = __uint_as_float((nm & m0) | (0xFF800000u & ~m0)); C1[r] = __uint_as_float((nm & m1) | (0xFF800000u & ~m1)); }
}
__device__ __forceinline__ bf16x8 ref_frag(float m, int hi) {
  const unsigned h0 = f2bf(m); const float r1 = m - bf2f(h0); const unsigned h1 = f2bf(r1); const float r2 = r1 - bf2f(h1); const unsigned h2 = f2bf(r2);
  u32x4 w = {hi ? 0u : (h0 | (h1 << 16)), hi ? 0u : h2, 0u, 0u};
  return __builtin_bit_cast(bf16x8, w);
}
template <int MODE, int THRL>
__device__ __forceinline__ void attn_unit(const Prm& P, char* shm, int b, int hc, int qb, bf16x8 (&qpre)[4], f32x4& cpre0, f32x4& cpre1, f32x4& cpre2, f32x4& cpre3, bool fetched = false, int pf_mode = 0, int pf_a = -1, LAS int* pf_slot = nullptr, const LAS float* kmax_tab = nullptr) {
  const int tid = threadIdx.x, lane = tid & 63, r32 = lane & 31, hi = lane >> 5; const int wid = __builtin_amdgcn_readfirstlane(tid >> 6);
  bf16* Q = (bf16*)(P.ws + WS_QQ); const bf16* K = (const bf16*)(P.ws + WS_KK); const bf16* V = (const bf16*)(P.ws + WS_VV); const bf16* GG = (const bf16*)(P.ws + WS_GG);
  const long rowbase = (long)b * SEQ; const int q0 = qb * QB;
  const int T0 = MODE == 2 ? (4 * qb - 8 > 0 ? 4 * qb - 8 : 0) : 0;
  int NT = 4 * qb + 4 - T0;
  const int TTOP = 4 * qb + 3;
  const int cw = 4 * qb + (wid >> 1);
#define TL(t) (MODE == 2 ? (t) : (TTOP - (t)))
  const bf16* Qw = Q + (rowbase + q0 + wid * QBLK) * DMP + hc * 64;
  const bf16* Kh = K + (rowbase + T0 * KVBLK) * DMP + hc * 64, *Vh = V + (rowbase + T0 * KVBLK) * DMP + hc * 64;
  const unsigned lds0 = (unsigned)(uintptr_t)shm;
  float* wsf = (float*)(shm + LDS_WS) + wid * 64;
  const LAS float* bias = (const LAS float*)((LAS char*)(uintptr_t)lds0 + LDS_BIAS);
  { LAS float* bw = (LAS float*)((LAS char*)(uintptr_t)lds0 + LDS_BIAS);
    if (MODE == 0 && !fetched) { const float* FL = (const float*)(P.ws + WS_FL) + ((size_t)b * 8 + hc) * SEQ; for (int i = tid; i < q0 + QB; i += NTHR) bw[i] = FL[i]; }
    if (MODE == 2) { const float far = P.rel[hc * 257 + 256]; const int tq = opaque_tid(); if (tq < 257) bw[tq] = (P.rel[hc * 257 + tq] - far) * LOG2E; } }
  const bf16* ksrc = Kh + (long)lane * DMP + wid * 8;
  const bf16* vsrc = Vh + (long)(16 * (wid & 3) + (lane >> 2)) * DMP + (wid >> 2) * 32 + (lane & 3) * 8;
  const unsigned kdst = lds0 + LDS_K + wid * 1024, vdst = lds0 + LDS_V + wid * 1024;
#define DMA_K(t, slot) glds16(ksrc + (long)TL(t) * KVBLK * DMP, (unsigned)__builtin_amdgcn_readfirstlane(kdst + (slot)))
#define DMA_V(t, slot) glds16(vsrc + (long)TL(t) * KVBLK * DMP, (unsigned)__builtin_amdgcn_readfirstlane(vdst + (slot)))
  const int vb0 = (int)(lds0 + LDS_V) + ((lane >> 4) & 1) * 32 + (lane & 3) * 8 + (4 * hi + ((lane & 15) >> 2)) * 64;
  const char* Kbase = shm + LDS_K; bf16x8 kf[8];
  const lds_cptr shm3 = (lds_cptr)(uintptr_t)lds0; const lds_cptr kp0 = shm3 + LDS_K + hi * 1024 + r32 * 16; const lds_cptr vp0 = shm3 + LDS_V + ((lane >> 4) & 1) * 32 + (lane & 3) * 8 + (4 * hi + ((lane & 15) >> 2)) * 64;
  const unsigned* msrc = (const unsigned*)(P.ws + WS_MASK) + (size_t)(rowbase + q0 + wid * QBLK + (lane >> 1)) * 128 + (lane & 1);
  const unsigned mdst = lds0 + LDS_BIAS + wid * 768;
  const LAS char* mrd = (const LAS char*)(uintptr_t)mdst;
  int ms0 = 0, ms1 = 256, ms2 = 512;
#define DMA_M(t, slot) glds4(msrc + 2 * (T0 + TL(t)), (unsigned)__builtin_amdgcn_readfirstlane(mdst + (slot)))
#define MROT() do { const int m_ = ms0; ms0 = ms1; ms1 = ms2; ms2 = m_; } while (0)
  if (!fetched) {
    if (MODE == 1) { DMA_M(0, 0); }
    DMA_K(0, 0); DMA_V(0, 0); DMA_K(1, SLOTB);
    if (MODE == 1) { DMA_M(1, 256); } }
  bf16x8 qr[4];
  if (fetched) {
#pragma unroll
    for (int d0 = 0; d0 < 4; ++d0) qr[d0] = qpre[d0]; }
  else { int l2 = lane; asm volatile("" : "+v"(l2)); const unsigned qo = (unsigned)((l2 & 31) * DMP + (l2 >> 5) * 8) * 2u;
#pragma unroll
    for (int d0 = 0; d0 < 4; ++d0) qr[d0] = *reinterpret_cast<const bf16x8*>((const char*)Qw + qo + d0 * 32); }
  if (MODE == 1) {
    f32x4 c0, c1, s0, s1;
    if (fetched) { c0 = cpre0; c1 = cpre1; s0 = cpre2; s1 = cpre3; }
    else { int l2 = lane; asm volatile("" : "+v"(l2)); const size_t ro = (size_t)(rowbase + q0 + wid * QBLK + (l2 & 31)) * 8;
      const float* cp = (const float*)(P.ws + WS_COS) + ro; const float* sp = (const float*)(P.ws + WS_SIN) + ro;
      c0 = *(const f32x4*)cp; c1 = *(const f32x4*)(cp + 4); s0 = *(const f32x4*)sp; s1 = *(const f32x4*)(sp + 4); }
    cpre0 = f32x4{}; cpre1 = f32x4{}; cpre2 = f32x4{}; cpre3 = f32x4{};
    u32x4 own = __builtin_bit_cast(u32x4, qr[0]), oth;
#pragma unroll
    for (int i = 0; i < 4; ++i) oth[i] = __shfl_xor(own[i], 32);
    const float sg = hi ? 1.f : -1.f;
    u32x4 res;
#pragma unroll
    for (int i = 0; i < 4; ++i) { const float cA = i < 2 ? c0[2 * i] : c1[2 * i - 4], cB = i < 2 ? c0[2 * i + 1] : c1[2 * i - 3], sA = i < 2 ? s0[2 * i] : s1[2 * i - 4], sB = i < 2 ? s0[2 * i + 1] : s1[2 * i - 3];
      const float a = bf2f(own[i] & 0xFFFFu) * cA + sg * bf2f(oth[i] & 0xFFFFu) * sA, b = bf2f(own[i] >> 16) * cB + sg * bf2f(oth[i] >> 16) * sB; res[i] = pk2(a, b); }
    qr[0] = __builtin_bit_cast(bf16x8, res);
  }
  if (MODE == 0) { float q2 = 0.f;
#pragma unroll
    for (int d0 = 0; d0 < 4; ++d0) { const u32x4 w = __builtin_bit_cast(u32x4, qr[d0]);
#pragma unroll
      for (int i = 0; i < 4; ++i) { const float x0 = bf2f(w[i] & 0xFFFFu), x1 = bf2f(w[i] >> 16); q2 += x0 * x0 + x1 * x1; } }
    q2 += __shfl_xor(q2, 32);
#pragma unroll
    for (int o = 1; o < 32; o <<= 1) q2 = fmaxf(q2, __shfl_xor(q2, o));
    if (lane == 0) ((LAS float*)((LAS char*)(uintptr_t)lds0 + LDS_VOTE))[wid] = q2; }
  LAS bf16x8* qst = (LAS bf16x8*)((LAS char*)(uintptr_t)lds0 + LDS_OST + wid * 4096) + lane;
#pragma unroll
  for (int d0 = 0; d0 < 4; ++d0) qst[d0 * 64] = qr[d0];
#define QLD(d0) (qst[(d0) * 64])
  float mhat = 0.f, l_reg = 0.f; f32x16 o[2]; o[0] = f32x16{}; o[1] = f32x16{}; f32x16 negm = f32x16{}; asm volatile("" : "+v"(negm));
  bf16x8 qx = ref_frag(0.f, hi); const bf16x8 kx = __builtin_bit_cast(bf16x8, (u32x4){hi ? 0u : 0xBF80BF80u, hi ? 0u : 0x0000BF80u, 0u, 0u});
#define CMASK(P0, P1, t) modify<MODE>(P0, P1, T0 + TL(t), cw, wid, r32, hi, bias, mhat)
  bool resc = false;
#define START(P0, P1) do { const float rm = rowmax(P0, P1); resc = false; \
    { const float dl = max2f(rm, FLOOR); mhat = fadd_s(mhat, dl); \
      _Pragma("unroll") for (int r = 0; r < 16; ++r) { P0[r] = fsub_s(P0[r], dl); P1[r] = fsub_s(P1[r], dl); } \
      if (MODE == 2) { _Pragma("unroll") for (int r = 0; r < 16; ++r) negm[r] = -mhat; asm volatile("" : "+v"(negm)); } \
      if (MODE == 0) qx = ref_frag(mhat, hi); } \
    _Pragma("unroll") for (int r = 0; r < 16; ++r) P0[r] = __builtin_amdgcn_exp2f(P0[r]); } while (0)
#define RESC() do { if (resc) { asm volatile("s_waitcnt lgkmcnt(0)" ::: "memory"); \
      _Pragma("unroll") for (int d_ = 0; d_ < 2; ++d_) _Pragma("unroll") for (int r = 0; r < 16; ++r) o[d_][r] *= wsf[crow(r, hi)]; } } while (0)
  f32x16 pA0, pA1, pB0, pB1;
  int sl_prev = 0, sl_cur = 0, sl_next = SLOTB;
#define ROT() do { sl_prev = sl_cur; sl_cur = sl_next; sl_next = (sl_next == (NSLOT - 1) * SLOTB) ? 0 : sl_next + SLOTB; } while (0)
  DMA_K(2, 2 * SLOTB);
  if (MODE == 1) { WAIT_BAR(4); } else { WAIT_BAR(3); }
  if (MODE == 0) { const LAS float* qm = (const LAS float*)((LAS char*)(uintptr_t)lds0 + LDS_VOTE);
    const f32x4 qa = *(const LAS f32x4*)qm, qb4 = *(const LAS f32x4*)(qm + 4);
    const float q2m = fmaxf(fmaxf(fmaxf(qa[0], qa[1]), fmaxf(qa[2], qa[3])), fmaxf(fmaxf(qb4[0], qb4[1]), fmaxf(qb4[2], qb4[3])));
    const float kmax2 = kmax_tab ? kmax_tab[hc] : __uint_as_float(__hip_atomic_load((const unsigned*)(P.ws + WS_CTL) + CW_KMAX + b * 8 + hc, __ATOMIC_RELAXED, __HIP_MEMORY_SCOPE_AGENT));
    const float D = 150.0f + (float)THRL + 2.0f * (sqrtf(q2m * kmax2) * 1.001f + 2.0f);
    const bool need = lane >= 4 * qb || !(bias[q0] - bias[64 * lane + 63] > D);
    const int gmin = (int)__builtin_ctzll(__ballot(need) | (1ull << 63));
    int nt = 4 * qb + 4 - gmin; nt += nt & 1; NT = nt < 4 ? 4 : nt; }
  if (MODE == 0) { bias_preload(pA0, pA1, bias, T0 + TL(0), hi); qkt<true>(pA0, pA1, Kbase, qr, negm, r32, hi); }
  else if (MODE == 1) { mask_preload(pA0, pA1, mrd + ms0, T0 + TL(0) > cw, mhat, r32, hi); qkt<true>(pA0, pA1, Kbase, qr, negm, r32, hi); }
  else qkt<false>(pA0, pA1, Kbase, qr, negm, r32, hi);
  asm volatile("s_nop 15\n\ts_nop 7" : "+v"(pA0), "+v"(pA1)); CMASK(pA0, pA1, 0);
  START(pA0, pA1);
  _Pragma("unroll") for (int r = 0; r < 16; ++r) pA1[r] = __builtin_amdgcn_exp2f(pA1[r]);
  WAIT_BAR(0);
  if (MODE == 1) { DMA_M(2, 512); MROT(); }
  DMA_K(3, 0); DMA_V(1, SLOTB);
  ROT();
  kload8(kf, kp0 + sl_cur);
  if (MODE == 1) { WAIT_BAR(3); } else { WAIT_BAR(2); }
  s16x4 vlo[8], vhi[8]; u32x4 pw0, pw1, pw2, pw3;
#define PKW(P, B) cvtpk_s(P[B], P[B + 1])
#define PAF(k) __builtin_bit_cast(bf16x8, pw##k)
#define VFR(i) (bf16x8){vlo[i][0], vlo[i][1], vlo[i][2], vlo[i][3], vhi[i][0], vhi[i][1], vhi[i][2], vhi[i][3]}
#define PIN(x) asm volatile("" : "+v"(x))
#define MX3(a, b, c) __builtin_fmaxf(__builtin_fmaxf((a), (b)), (c))
#define GAPA(MF, A0, A1, A2, A3, W0, W1, PW) do { MF; sacc += A0; sacc += A1; sacc += A2; sacc += A3; PIN(sacc); W0; W1; PIN(PW); SBAR(); } while (0)
#define EX(v) __builtin_amdgcn_exp2f(v)
#define GAPB(MF, X, B) do { MF; X[B] = EX(X[B]); X[B + 1] = EX(X[B + 1]); X[B + 2] = EX(X[B + 2]); X[B + 3] = EX(X[B + 3]); PIN(X); SBAR(); } while (0)
#define VRD(i) do { vlo[i] = vtr(vp_ + (((i) >> 2) * 4096 + ((i) & 3) * 1024)); vhi[i] = vtr(vp_ + (((i) >> 2) * 4096 + ((i) & 3) * 1024 + 512)); } while (0)
#define KRD(G, j) do { if (G) { kload2(kf, kp0 + sl_next, j); SBAR(); } } while (0)
#define STEP(C0, C1, P0, P1, t, GK, GV, GL, GM) do { SBAR(); \
    if (MODE == 0) { bias_preload(C0, C1, bias, T0 + TL(t), hi); SBAR(); \
      C0 = __builtin_amdgcn_mfma_f32_32x32x16_bf16(kx, qx, C0, 0, 0, 0); C1 = __builtin_amdgcn_mfma_f32_32x32x16_bf16(kx, qx, C1, 0, 0, 0); SBAR(); } \
    if (MODE == 1) { mask_preload(C0, C1, mrd + ms0, T0 + TL(t) > cw, mhat, r32, hi); SBAR(); } \
    const lds_cptr vp_ = vp0 + sl_prev; \
    VRD(0); bf16x8 q_ = QLD(0); SBAR(); float sacc = (P0[0] + P0[1]); \
    GAPA(C0 = __builtin_amdgcn_mfma_f32_32x32x16_bf16(kf[0], q_, MODE != 2 ? C0 : negm, 0, 0, 0), P0[2], P0[3], P0[4], P0[5],     pw0[0] = PKW(P0, 0), pw0[1] = PKW(P0, 2), pw0); \
    VRD(4); SBAR(); GAPA(C1 = __builtin_amdgcn_mfma_f32_32x32x16_bf16(kf[1], q_, MODE != 2 ? C1 : negm, 0, 0, 0), P0[6], P0[7], P0[8], P0[9],     pw0[2] = PKW(P0, 4), pw0[3] = PKW(P0, 6), pw0); \
    VRD(1); q_ = QLD(1); SBAR(); GAPA(C0 = __builtin_amdgcn_mfma_f32_32x32x16_bf16(kf[2], q_, C0, 0, 0, 0),   P0[10], P0[11], P0[12], P0[13], pw1[0] = PKW(P0, 8), pw1[1] = PKW(P0, 10), pw1); \
    VRD(5); SBAR(); GAPA(C1 = __builtin_amdgcn_mfma_f32_32x32x16_bf16(kf[3], q_, C1, 0, 0, 0),   P0[14], P0[15], P1[0], P1[1],   pw1[2] = PKW(P0, 12), pw1[3] = PKW(P0, 14), pw1); \
    VRD(2); q_ = QLD(2); SBAR(); GAPA(C0 = __builtin_amdgcn_mfma_f32_32x32x16_bf16(kf[4], q_, C0, 0, 0, 0),   P1[2], P1[3], P1[4], P1[5],     pw2[0] = PKW(P1, 0), pw2[1] = PKW(P1, 2), pw2); \
    VRD(6); SBAR(); GAPA(C1 = __builtin_amdgcn_mfma_f32_32x32x16_bf16(kf[5], q_, C1, 0, 0, 0),   P1[6], P1[7], P1[8], P1[9],     pw2[2] = PKW(P1, 4), pw2[3] = PKW(P1, 6), pw2); \
    VRD(3); q_ = QLD(3); SBAR(); GAPA(C0 = __builtin_amdgcn_mfma_f32_32x32x16_bf16(kf[6], q_, C0, 0, 0, 0),   P1[10], P1[11], P1[12], P1[13], pw3[0] = PKW(P1, 8), pw3[1] = PKW(P1, 10), pw3); \
    VRD(7); SBAR(); GAPA(C1 = __builtin_amdgcn_mfma_f32_32x32x16_bf16(kf[7], q_, C1, 0, 0, 0),   P1[14], P1[15], 0.f, 0.f,       pw3[2] = PKW(P1, 12), pw3[3] = PKW(P1, 14), pw3); \
    l_reg += sacc; \
    if (MODE == 1 && (GM)) { DMA_M((t) + 2, ms2); } if (GK) { DMA_K((t) + 3, sl_cur); } if (GV) { DMA_V((t) + 1, sl_next); } \
    CMASK(C0, C1, t); \
    { float a = MX3(C0[0], C0[1], C1[0]), b = MX3(C0[2], C0[3], C1[1]); a = MX3(a, C1[2], C1[3]); \
      _Pragma("unroll") for (int r = 4; r < 16; r += 4) { a = MX3(a, C0[r], C0[r + 1]); b = MX3(b, C0[r + 2], C0[r + 3]); a = MX3(a, C1[r], C1[r + 1]); b = MX3(b, C1[r + 2], C1[r + 3]); } \
      float rm = __builtin_fmaxf(a, b); { auto rr = __builtin_amdgcn_permlane32_swap(__float_as_uint(rm), __float_as_uint(rm), false, false); rm = __builtin_fmaxf(__uint_as_float(rr[0]), __uint_as_float(rr[1])); } \
      resc = false; \
      if (__builtin_expect(__any(rm > (float)THRL), 0)) { const float dl = __builtin_fmaxf(rm, 0.f); mhat += dl; \
        _Pragma("unroll") for (int r = 0; r < 16; ++r) { C0[r] -= dl; C1[r] -= dl; } \
        if (MODE == 2) { _Pragma("unroll") for (int r = 0; r < 16; ++r) negm[r] = -mhat; asm volatile("" : "+v"(negm)); } \
        if (MODE == 0) qx = ref_frag(mhat, hi); \
        const float f = __builtin_amdgcn_exp2f(-dl); l_reg *= f; if (hi == 0) wsf[r32] = f; resc = true; } } \
    SBAR(); \
    GAPB(o[0] = __builtin_amdgcn_mfma_f32_32x32x16_bf16(PAF(0), VFR(0), o[0], 0, 0, 0), C0, 0); \
    GAPB(o[1] = __builtin_amdgcn_mfma_f32_32x32x16_bf16(PAF(0), VFR(4), o[1], 0, 0, 0), C0, 4); \
    KRD(GL, 0); GAPB(o[0] = __builtin_amdgcn_mfma_f32_32x32x16_bf16(PAF(1), VFR(1), o[0], 0, 0, 0), C0, 8); \
    KRD(GL, 1); GAPB(o[1] = __builtin_amdgcn_mfma_f32_32x32x16_bf16(PAF(1), VFR(5), o[1], 0, 0, 0), C0, 12); \
    KRD(GL, 2); GAPB(o[0] = __builtin_amdgcn_mfma_f32_32x32x16_bf16(PAF(2), VFR(2), o[0], 0, 0, 0), C1, 0); \
    KRD(GL, 3); GAPB(o[1] = __builtin_amdgcn_mfma_f32_32x32x16_bf16(PAF(2), VFR(6), o[1], 0, 0, 0), C1, 4); \
    GAPB(o[0] = __builtin_amdgcn_mfma_f32_32x32x16_bf16(PAF(3), VFR(3), o[0], 0, 0, 0), C1, 8); \
    GAPB(o[1] = __builtin_amdgcn_mfma_f32_32x32x16_bf16(PAF(3), VFR(7), o[1], 0, 0, 0), C1, 12); \
    } while (0)
  int t = 1;
#define WAITS() do { if (MODE == 1) { WAIT_BAR(3); } else { WAIT_BAR(2); } } while (0)
  for (; t + 5 < NT; t += 2) {
    STEP(pB0, pB1, pA0, pA1, t, true, true, true, true);     WAITS(); RESC(); ROT(); MROT();
    STEP(pA0, pA1, pB0, pB1, t + 1, true, true, true, true); WAITS(); RESC(); ROT(); MROT();
  }
#define ENDW(tt) do { if ((tt) + 3 < NT) { WAITS(); } else if ((tt) + 2 < NT) { if (MODE == 1) { WAIT_BAR(2); } else { WAIT_BAR(1); } } else { WAIT_BAR(0); } } while (0)
  for (; t + 1 < NT; t += 2) {
    STEP(pB0, pB1, pA0, pA1, t, (t + 3 < NT), (t + 1 < NT), (t + 1 < NT), (t + 2 < NT));         ENDW(t);     RESC(); ROT(); MROT();
    STEP(pA0, pA1, pB0, pB1, t + 1, (t + 4 < NT), (t + 2 < NT), (t + 2 < NT), (t + 3 < NT));     ENDW(t + 1); RESC(); ROT(); MROT();
  }
  STEP(pB0, pB1, pA0, pA1, NT - 1, false, false, false, false); RESC();
  const bf16* Gw = GG + (rowbase + q0 + wid * QBLK) * DMP + hc * 64;
  u32x4 gq[4];
#pragma unroll
  for (int i = 0; i < 4; ++i) gq[i] = *(const u32x4*)(Gw + (long)(i * 8 + (lane >> 3)) * DMP + (lane & 7) * 8);
  { float sacc = pB0[0] + pB0[1]; _Pragma("unroll") for (int r = 2; r < 16; ++r) sacc += pB0[r]; _Pragma("unroll") for (int r = 0; r < 16; ++r) sacc += pB1[r]; l_reg += sacc;
    pw0 = (u32x4){PKW(pB0, 0), PKW(pB0, 2), PKW(pB0, 4), PKW(pB0, 6)}; pw1 = (u32x4){PKW(pB0, 8), PKW(pB0, 10), PKW(pB0, 12), PKW(pB0, 14)}; pw2 = (u32x4){PKW(pB1, 0), PKW(pB1, 2), PKW(pB1, 4), PKW(pB1, 6)}; pw3 = (u32x4){PKW(pB1, 8), PKW(pB1, 10), PKW(pB1, 12), PKW(pB1, 14)};
    SBAR(); pv(o, vb0 + sl_cur, PAF(0), PAF(1), PAF(2), PAF(3)); }
  if (MODE != 2 && pf_mode != 0) {
    if (pf_mode == 2 && tid == 0) *pf_slot = pf_a;
    asm volatile("s_waitcnt lgkmcnt(0)\n\ts_barrier" ::: "memory");
    int nhc = hc, nqb = pf_a;
    if (pf_mode == 2) { const int nx = __builtin_amdgcn_readfirstlane(*pf_slot); nhc = nx & 7; nqb = nx < 128 ? 15 - (nx >> 3) : -1; }
    if (nqb >= 0) {
      const int ntop = 4 * nqb + 3;
      const bf16* kn = K + rowbase * DMP + nhc * 64 + (long)ntop * KVBLK * DMP; const bf16* vn = V + rowbase * DMP + nhc * 64 + (long)ntop * KVBLK * DMP;
      const unsigned* mn = (const unsigned*)(P.ws + WS_MASK) + (size_t)(rowbase + nqb * QB + wid * QBLK) * 128 + 2 * ntop;
      const unsigned ko = (unsigned)(lane * DMP + wid * 8) * 2u, vo = (unsigned)((16 * (wid & 3) + (lane >> 2)) * DMP + (wid >> 2) * 32 + (lane & 3) * 8) * 2u, mo = (unsigned)((lane >> 1) * 128 + (lane & 1)) * 4u;
      if (MODE == 1) glds4s(mn, mo, (unsigned)__builtin_amdgcn_readfirstlane(mdst));
      glds16s(kn, ko, (unsigned)__builtin_amdgcn_readfirstlane(kdst)); glds16s(vn, vo, (unsigned)__builtin_amdgcn_readfirstlane(vdst)); glds16s(kn - (long)KVBLK * DMP, ko, (unsigned)__builtin_amdgcn_readfirstlane(kdst + SLOTB));
      if (MODE == 1) glds4s(mn - 2, mo, (unsigned)__builtin_amdgcn_readfirstlane(mdst + 256));
      { const char* Qn = (const char*)(Q + (rowbase + nqb * QB + wid * QBLK) * DMP + nhc * 64);
        int l2 = lane; asm volatile("" : "+v"(l2));
        const unsigned qo = (unsigned)((l2 & 31) * DMP + (l2 >> 5) * 8) * 2u;
#pragma unroll
        for (int d0 = 0; d0 < 4; ++d0) qpre[d0] = *reinterpret_cast<const bf16x8*>(Qn + qo + d0 * 32); }
      if (MODE == 1) { int l3 = lane; asm volatile("" : "+v"(l3)); const size_t ro = (size_t)(rowbase + nqb * QB + wid * QBLK + (l3 & 31)) * 8;
        const float* cp = (const float*)(P.ws + WS_COS) + ro; const float* sp = (const float*)(P.ws + WS_SIN) + ro;
        cpre0 = *(const f32x4*)cp; cpre1 = *(const f32x4*)(cp + 4); cpre2 = *(const f32x4*)sp; cpre3 = *(const f32x4*)(sp + 4); }
      if (MODE == 0) { const unsigned* fn = (const unsigned*)(P.ws + WS_FL) + ((size_t)b * 8 + nhc) * SEQ;
        const unsigned fo = (unsigned)lane * 4u; const int lim = 4 * (nqb + 1);
#pragma unroll
        for (int k = 0; k < 8; ++k) { const int c = wid + NW * k; if (c < lim) glds4s(fn + 64 * c, fo, (unsigned)__builtin_amdgcn_readfirstlane(lds0 + LDS_BIAS + 256 * c)); } } } }
#undef PKW
#undef PAF
#undef VFR
#undef PIN
#undef MX3
#undef GAPA
#undef GAPB
#undef EX
#undef VRD
#undef KRD
#undef STEP
#undef ENDW
#undef WAITS
  { auto rr = __builtin_amdgcn_permlane32_swap(__float_as_uint(l_reg), __float_as_uint(l_reg), false, false); l_reg = __uint_as_float(rr[0]) + __uint_as_float(rr[1]); }
  if (hi == 0) wsf[32 + r32] = l_reg; asm volatile("s_waitcnt lgkmcnt(0)" ::: "memory");
  float rli[16];
#pragma unroll
  for (int r = 0; r < 16; ++r) rli[r] = __builtin_amdgcn_rcpf(wsf[32 + crow(r, hi)]);
#if defined(REP_PHASE)
  int oalt_ = P.o_alt; asm volatile("" : "+s"(oalt_));
  bf16* Ow = (oalt_ ? (bf16*)(P.ws + WS_Y) : Q) + (rowbase + q0 + wid * QBLK) * DMP + hc * 64;
#else
  bf16* Ow = Q + (rowbase + q0 + wid * QBLK) * DMP + hc * 64;
#endif
  { bf16* stg = (bf16*)(shm + LDS_OST) + wid * 2048;
#pragma unroll
    for (int r = 0; r < 16; ++r) { const int orow = crow(r, hi);
#pragma unroll
      for (int d0 = 0; d0 < 2; ++d0) stg[orow * 64 + d0 * 32 + r32] = (bf16)f2bf(o[d0][r] * rli[r]); }
    asm volatile("s_waitcnt lgkmcnt(0)" ::: "memory");
#pragma unroll
    for (int i = 0; i < 4; ++i) { const int row = i * 8 + (lane >> 3), ch = lane & 7; const u32x4 v = *(const u32x4*)(stg + row * 64 + ch * 8);
      u32x4 w;
#pragma unroll
      for (int k = 0; k < 4; ++k) { const float g0 = bf2f(gq[i][k] & 0xFFFFu), g1 = bf2f(gq[i][k] >> 16);
        const float a0 = bf2f(v[k] & 0xFFFFu) * g0 * __builtin_amdgcn_rcpf(1.f + __expf(-g0)), a1 = bf2f(v[k] >> 16) * g1 * __builtin_amdgcn_rcpf(1.f + __expf(-g1)); w[k] = pk2(a0, a1); }
      *(u32x4*)(Ow + (long)row * DMP + ch * 8) = w; } }
  asm volatile("s_waitcnt vmcnt(0) lgkmcnt(0)\n\ts_barrier" ::: "memory");
#undef DMA_K
#undef DMA_V
#undef DMA_M
#undef MROT
#undef CMASK
#undef START
#undef RESC
#undef ROT
#undef TL
#undef QLD
}
__device__ __forceinline__ void band_modify(f32x16& P0, f32x16& P1, bool valid, int step, int wid, int r32, int hi, const LAS float* bias) {
  const float NEG = -INFINITY;
  if (!valid) {
#pragma unroll
    for (int r = 0; r < 16; ++r) { P0[r] = NEG; P1[r] = NEG; }
  } else if (step >= 6) { const int qoff = 64 * (8 - step) + 32 * (wid & 1) + r32 + 128;
#pragma unroll
    for (int r = 0; r < 16; ++r) { int i0 = qoff - crow(r, hi), i1 = i0 - 32; i0 = i0 > 256 ? 256 : i0; i1 = i1 > 256 ? 256 : i1; P0[r] += bias[i0]; P1[r] += bias[i1]; } }
}
__device__ __forceinline__ void attn_band_unit(const Prm& P, char* shm, int b, int hc, int qb, bf16x8 (&qpre)[4], bool fetched, bool fetch_next) {
  constexpr int MODE = 2, THRL = 8;
  constexpr int B_NS = 6, B_K = 0, B_V = B_NS * SLOTB, B_WS = 2 * B_NS * SLOTB, B_OST = B_WS + NW * 64 * 4, B_END = B_OST + NW * 4096, B_BIAS = B_END;
  static_assert(B_BIAS + 2048 <= MISC_OFF, "band attention LDS map");
  const int tid = threadIdx.x, lane = tid & 63, r32 = lane & 31, hi = lane >> 5; const int wid = __builtin_amdgcn_readfirstlane(tid >> 6);
  bf16* Q = (bf16*)(P.ws + WS_QQ); const bf16* K = (const bf16*)(P.ws + WS_KK); const bf16* V = (const bf16*)(P.ws + WS_VV); const bf16* GG = (const bf16*)(P.ws + WS_GG);
  const long rowbase = (long)b * SEQ; const int q0 = qb * QB;
  const int g0 = 4 * qb - 8, jp = wid >> 1;
  const int T0 = 0, cw = 4 * qb + jp; int NT = 12; const int TTOP = 0; (void)NT; (void)TTOP; (void)cw;
#define TL(t) (g0 + (t) > 0 ? g0 + (t) : 0)
#define SLOT(n) ((((n) + 6) % 6) * SLOTB)
#define SLW(c) (((((c) + 6) % 6) + jp >= 6 ? (((c) + 6) % 6) + jp - 6 : (((c) + 6) % 6) + jp) * SLOTB)
  const bf16* Qw = Q + (rowbase + q0 + wid * QBLK) * DMP + hc * 64;
  const bf16* Kh = K + (rowbase + T0 * KVBLK) * DMP + hc * 64, *Vh = V + (rowbase + T0 * KVBLK) * DMP + hc * 64;
  const unsigned lds0 = (unsigned)(uintptr_t)shm;
  float* wsf = (float*)(shm + B_WS) + wid * 64;
  const LAS float* bias = (const LAS float*)((LAS char*)(uintptr_t)lds0 + B_BIAS);
  { LAS float* bw = (LAS float*)((LAS char*)(uintptr_t)lds0 + B_BIAS);
    if (MODE == 0) { const float* FL = (const float*)(P.ws + WS_FL) + ((size_t)b * 8 + hc) * SEQ; for (int i = tid; i < q0 + QB; i += NTHR) bw[i] = FL[i]; }
    if (MODE == 2 && !fetched) { const float far = P.rel[hc * 257 + 256]; const int tq = opaque_tid(); if (tq < 257) bw[tq] = (P.rel[hc * 257 + tq] - far) * LOG2E; } }
  const bf16* ksrc = Kh + (long)lane * DMP + wid * 8;
  const bf16* vsrc = Vh + (long)(16 * (wid & 3) + (lane >> 2)) * DMP + (wid >> 2) * 32 + (lane & 3) * 8;
  const unsigned kdst = lds0 + B_K + wid * 1024, vdst = lds0 + B_V + wid * 1024;
#define DMA_K(t, slot) glds16(ksrc + (long)TL(t) * KVBLK * DMP, (unsigned)__builtin_amdgcn_readfirstlane(kdst + (slot)))
#define DMA_V(t, slot) glds16(vsrc + (long)TL(t) * KVBLK * DMP, (unsigned)__builtin_amdgcn_readfirstlane(vdst + (slot)))
  const int vb0 = (int)(lds0 + B_V) + ((lane >> 4) & 1) * 32 + (lane & 3) * 8 + (4 * hi + ((lane & 15) >> 2)) * 64;
  const char* Kbase = shm + B_K; bf16x8 kf[8];
  const lds_cptr shm3 = (lds_cptr)(uintptr_t)lds0; const lds_cptr kp0 = shm3 + B_K + hi * 1024 + r32 * 16; const lds_cptr vp0 = shm3 + B_V + ((lane >> 4) & 1) * 32 + (lane & 3) * 8 + (4 * hi + ((lane & 15) >> 2)) * 64;
  const unsigned* msrc = (const unsigned*)(P.ws + WS_MASK) + (size_t)(rowbase + q0 + wid * QBLK + (lane >> 1)) * 128 + (lane & 1);
  const unsigned mdst = lds0 + B_BIAS + wid * 768;
  const LAS char* mrd = (const LAS char*)(uintptr_t)mdst;
  int ms0 = 0, ms1 = 256, ms2 = 512;
#define DMA_M(t, slot) glds4(msrc + 2 * (T0 + TL(t)), (unsigned)__builtin_amdgcn_readfirstlane(mdst + (slot)))
#define MROT() do { const int m_ = ms0; ms0 = ms1; ms1 = ms2; ms2 = m_; } while (0)
  if (!fetched) { DMA_K(0, SLOT(0)); DMA_V(0, SLOT(0)); DMA_K(1, SLOT(1)); DMA_V(1, SLOT(1)); DMA_K(2, SLOT(2)); DMA_V(2, SLOT(2)); DMA_K(3, SLOT(3)); DMA_V(3, SLOT(3)); DMA_K(4, SLOT(4)); DMA_K(5, SLOT(5)); }
  bf16x8 qr[4];
  if (fetched) {
#pragma unroll
    for (int d0 = 0; d0 < 4; ++d0) qr[d0] = qpre[d0]; }
  else { int l2 = lane; asm volatile("" : "+v"(l2)); const unsigned qo = (unsigned)((l2 & 31) * DMP + (l2 >> 5) * 8) * 2u;
#pragma unroll
    for (int d0 = 0; d0 < 4; ++d0) qr[d0] = *reinterpret_cast<const bf16x8*>((const char*)Qw + qo + d0 * 32); }
  if (MODE == 1) {
    const float* cp = (const float*)(P.ws + WS_COS) + (size_t)(rowbase + q0 + wid * QBLK + r32) * 8; const float* sp = (const float*)(P.ws + WS_SIN) + (size_t)(rowbase + q0 + wid * QBLK + r32) * 8;
    const f32x4 c0 = *(const f32x4*)cp, c1 = *(const f32x4*)(cp + 4), s0 = *(const f32x4*)sp, s1 = *(const f32x4*)(sp + 4);
    u32x4 own = __builtin_bit_cast(u32x4, qr[0]), oth;
#pragma unroll
    for (int i = 0; i < 4; ++i) oth[i] = __shfl_xor(own[i], 32);
    const float sg = hi ? 1.f : -1.f;
    u32x4 res;
#pragma unroll
    for (int i = 0; i < 4; ++i) { const float cA = i < 2 ? c0[2 * i] : c1[2 * i - 4], cB = i < 2 ? c0[2 * i + 1] : c1[2 * i - 3], sA = i < 2 ? s0[2 * i] : s1[2 * i - 4], sB = i < 2 ? s0[2 * i + 1] : s1[2 * i - 3];
      const float a = bf2f(own[i] & 0xFFFFu) * cA + sg * bf2f(oth[i] & 0xFFFFu) * sA, b = bf2f(own[i] >> 16) * cB + sg * bf2f(oth[i] >> 16) * sB; res[i] = pk2(a, b); }
    qr[0] = __builtin_bit_cast(bf16x8, res);
  }
  if (MODE == 0) { float q2 = 0.f;
#pragma unroll
    for (int d0 = 0; d0 < 4; ++d0) { const u32x4 w = __builtin_bit_cast(u32x4, qr[d0]);
#pragma unroll
      for (int i = 0; i < 4; ++i) { const float x0 = bf2f(w[i] & 0xFFFFu), x1 = bf2f(w[i] >> 16); q2 += x0 * x0 + x1 * x1; } }
    q2 += __shfl_xor(q2, 32);
#pragma unroll
    for (int o = 1; o < 32; o <<= 1) q2 = fmaxf(q2, __shfl_xor(q2, o));
    if (lane == 0) ((LAS float*)((LAS char*)(uintptr_t)lds0 + LDS_VOTE))[wid] = q2; }
  LAS bf16x8* qst = (LAS bf16x8*)((LAS char*)(uintptr_t)lds0 + B_OST + wid * 4096) + lane;
#pragma unroll
  for (int d0 = 0; d0 < 4; ++d0) qst[d0 * 64] = qr[d0];
#define QLD(d0) (qst[(d0) * 64])
  float mhat = 0.f, l_reg = 0.f; f32x16 o[2]; o[0] = f32x16{}; o[1] = f32x16{}; f32x16 negm = f32x16{}; asm volatile("" : "+v"(negm));
#define CMASK(P0, P1, t) band_modify(P0, P1, g0 + (t) + jp >= 0, (t), wid, r32, hi, bias)
  bool resc = false;
#define START(P0, P1) do { const float rm = rowmax(P0, P1); resc = false; \
    { const float dl = max2f(rm, FLOOR); mhat = fadd_s(mhat, dl); \
      _Pragma("unroll") for (int r = 0; r < 16; ++r) { P0[r] = fsub_s(P0[r], dl); P1[r] = fsub_s(P1[r], dl); } \
      if (MODE == 2) { _Pragma("unroll") for (int r = 0; r < 16; ++r) negm[r] = -mhat; asm volatile("" : "+v"(negm)); } } \
    _Pragma("unroll") for (int r = 0; r < 16; ++r) P0[r] = __builtin_amdgcn_exp2f(P0[r]); } while (0)
#define RESC() do { if (resc) { asm volatile("s_waitcnt lgkmcnt(0)" ::: "memory"); \
      _Pragma("unroll") for (int d_ = 0; d_ < 2; ++d_) _Pragma("unroll") for (int r = 0; r < 16; ++r) o[d_][r] *= wsf[crow(r, hi)]; } } while (0)
  f32x16 pA0, pA1, pB0, pB1;
#define ROT() do { sl_prev = sl_cur; sl_cur = sl_next; sl_next = (sl_next == (B_NS - 1) * SLOTB) ? 0 : sl_next + SLOTB; } while (0)
  WAIT_BAR(0);
  if (MODE == 0) { const LAS float* qm = (const LAS float*)((LAS char*)(uintptr_t)lds0 + LDS_VOTE);
    const f32x4 qa = *(const LAS f32x4*)qm, qb4 = *(const LAS f32x4*)(qm + 4);
    const float q2m = fmaxf(fmaxf(fmaxf(qa[0], qa[1]), fmaxf(qa[2], qa[3])), fmaxf(fmaxf(qb4[0], qb4[1]), fmaxf(qb4[2], qb4[3])));
    const float kmax2 = __uint_as_float(__hip_atomic_load((const unsigned*)(P.ws + WS_CTL) + CW_KMAX + b * 8 + hc, __ATOMIC_RELAXED, __HIP_MEMORY_SCOPE_AGENT));
    const float D = 150.0f + (float)THRL + 2.0f * (sqrtf(q2m * kmax2) * 1.001f + 2.0f);
    const bool need = lane >= 4 * qb || !(bias[q0] - bias[64 * lane + 63] > D);
    const int gmin = (int)__builtin_ctzll(__ballot(need) | (1ull << 63));
    int nt = 4 * qb + 4 - gmin; nt += nt & 1; NT = nt < 4 ? 4 : nt; }
  if (MODE == 0) { bias_preload(pA0, pA1, bias, T0 + TL(0), hi); qkt<true>(pA0, pA1, Kbase, qr, negm, r32, hi); }
  else if (MODE == 1) { mask_preload(pA0, pA1, mrd + ms0, T0 + TL(0) > cw, mhat, r32, hi); qkt<true>(pA0, pA1, Kbase, qr, negm, r32, hi); }
  else qkt<false>(pA0, pA1, Kbase + SLW(0), qr, negm, r32, hi);
  asm volatile("s_nop 15\n\ts_nop 7" : "+v"(pA0), "+v"(pA1)); CMASK(pA0, pA1, 0);
  START(pA0, pA1);
  _Pragma("unroll") for (int r = 0; r < 16; ++r) pA1[r] = __builtin_amdgcn_exp2f(pA1[r]);
  WAIT_BAR(0);
  DMA_K(6, SLOT(0)); DMA_V(4, SLOT(4));
  kload8(kf, kp0 + SLW(1));
  WAIT_BAR(2);
  s16x4 vlo[8], vhi[8]; u32x4 pw0, pw1, pw2, pw3;
#define PKW(P, B) cvtpk_s(P[B], P[B + 1])
#define PAF(k) __builtin_bit_cast(bf16x8, pw##k)
#define VFR(i) (bf16x8){vlo[i][0], vlo[i][1], vlo[i][2], vlo[i][3], vhi[i][0], vhi[i][1], vhi[i][2], vhi[i][3]}
#define PIN(x) asm volatile("" : "+v"(x))
#define MX3(a, b, c) __builtin_fmaxf(__builtin_fmaxf((a), (b)), (c))
#define GAPA(MF, A0, A1, A2, A3, W0, W1, PW) do { MF; sacc += A0; sacc += A1; sacc += A2; sacc += A3; PIN(sacc); W0; W1; PIN(PW); SBAR(); } while (0)
#define EX(v) __builtin_amdgcn_exp2f(v)
#define GAPB(MF, X, B) do { MF; X[B] = EX(X[B]); X[B + 1] = EX(X[B + 1]); X[B + 2] = EX(X[B + 2]); X[B + 3] = EX(X[B + 3]); PIN(X); SBAR(); } while (0)
#define VRD(i) do { vlo[i] = vtr(vp_ + (((i) >> 2) * 4096 + ((i) & 3) * 1024)); vhi[i] = vtr(vp_ + (((i) >> 2) * 4096 + ((i) & 3) * 1024 + 512)); } while (0)
#define KRD(G, j) do { if (G) { kload2(kf, kp0 + sl_next, j); SBAR(); } } while (0)
#define STEP(C0, C1, P0, P1, t, GK, GV, GL, GM) do { SBAR(); const int sl_next = SLW((t) + 1); \
    if (MODE == 0) { bias_preload(C0, C1, bias, T0 + TL(t), hi); SBAR(); } \
    if (MODE == 1) { mask_preload(C0, C1, mrd + ms0, T0 + TL(t) > cw, mhat, r32, hi); SBAR(); } \
    const lds_cptr vp_ = vp0 + SLW((t) - 1); \
    VRD(0); bf16x8 q_ = QLD(0); SBAR(); float sacc = (P0[0] + P0[1]); \
    GAPA(C0 = __builtin_amdgcn_mfma_f32_32x32x16_bf16(kf[0], q_, MODE != 2 ? C0 : negm, 0, 0, 0), P0[2], P0[3], P0[4], P0[5],     pw0[0] = PKW(P0, 0), pw0[1] = PKW(P0, 2), pw0); \
    VRD(4); SBAR(); GAPA(C1 = __builtin_amdgcn_mfma_f32_32x32x16_bf16(kf[1], q_, MODE != 2 ? C1 : negm, 0, 0, 0), P0[6], P0[7], P0[8], P0[9],     pw0[2] = PKW(P0, 4), pw0[3] = PKW(P0, 6), pw0); \
    VRD(1); q_ = QLD(1); SBAR(); GAPA(C0 = __builtin_amdgcn_mfma_f32_32x32x16_bf16(kf[2], q_, C0, 0, 0, 0),   P0[10], P0[11], P0[12], P0[13], pw1[0] = PKW(P0, 8), pw1[1] = PKW(P0, 10), pw1); \
    VRD(5); SBAR(); GAPA(C1 = __builtin_amdgcn_mfma_f32_32x32x16_bf16(kf[3], q_, C1, 0, 0, 0),   P0[14], P0[15], P1[0], P1[1],   pw1[2] = PKW(P0, 12), pw1[3] = PKW(P0, 14), pw1); \
    VRD(2); q_ = QLD(2); SBAR(); GAPA(C0 = __builtin_amdgcn_mfma_f32_32x32x16_bf16(kf[4], q_, C0, 0, 0, 0),   P1[2], P1[3], P1[4], P1[5],     pw2[0] = PKW(P1, 0), pw2[1] = PKW(P1, 2), pw2); \
    VRD(6); SBAR(); GAPA(C1 = __builtin_amdgcn_mfma_f32_32x32x16_bf16(kf[5], q_, C1, 0, 0, 0),   P1[6], P1[7], P1[8], P1[9],     pw2[2] = PKW(P1, 4), pw2[3] = PKW(P1, 6), pw2); \
    VRD(3); q_ = QLD(3); SBAR(); GAPA(C0 = __builtin_amdgcn_mfma_f32_32x32x16_bf16(kf[6], q_, C0, 0, 0, 0),   P1[10], P1[11], P1[12], P1[13], pw3[0] = PKW(P1, 8), pw3[1] = PKW(P1, 10), pw3); \
    VRD(7); SBAR(); GAPA(C1 = __builtin_amdgcn_mfma_f32_32x32x16_bf16(kf[7], q_, C1, 0, 0, 0),   P1[14], P1[15], 0.f, 0.f,       pw3[2] = PKW(P1, 12), pw3[3] = PKW(P1, 14), pw3); \
    l_reg += sacc; \
    if (GK) { DMA_K((t) + 6, SLOT(t)); } if (GV) { DMA_V((t) + 4, SLOT((t) + 4)); } \
    CMASK(C0, C1, t); \
    { float a = MX3(C0[0], C0[1], C1[0]), b = MX3(C0[2], C0[3], C1[1]); a = MX3(a, C1[2], C1[3]); \
      _Pragma("unroll") for (int r = 4; r < 16; r += 4) { a = MX3(a, C0[r], C0[r + 1]); b = MX3(b, C0[r + 2], C0[r + 3]); a = MX3(a, C1[r], C1[r + 1]); b = MX3(b, C1[r + 2], C1[r + 3]); } \
      float rm = __builtin_fmaxf(a, b); { auto rr = __builtin_amdgcn_permlane32_swap(__float_as_uint(rm), __float_as_uint(rm), false, false); rm = __builtin_fmaxf(__uint_as_float(rr[0]), __uint_as_float(rr[1])); } \
      resc = false; \
      if (__builtin_expect(__any(rm > (float)THRL), 0)) { const float dl = __builtin_fmaxf(rm, 0.f); mhat += dl; \
        _Pragma("unroll") for (int r = 0; r < 16; ++r) { C0[r] -= dl; C1[r] -= dl; } \
        if (MODE == 2) { _Pragma("unroll") for (int r = 0; r < 16; ++r) negm[r] = -mhat; asm volatile("" : "+v"(negm)); } \
        const float f = __builtin_amdgcn_exp2f(-dl); l_reg *= f; if (hi == 0) wsf[r32] = f; resc = true; } } \
    SBAR(); \
    GAPB(o[0] = __builtin_amdgcn_mfma_f32_32x32x16_bf16(PAF(0), VFR(0), o[0], 0, 0, 0), C0, 0); \
    GAPB(o[1] = __builtin_amdgcn_mfma_f32_32x32x16_bf16(PAF(0), VFR(4), o[1], 0, 0, 0), C0, 4); \
    KRD(GL, 0); GAPB(o[0] = __builtin_amdgcn_mfma_f32_32x32x16_bf16(PAF(1), VFR(1), o[0], 0, 0, 0), C0, 8); \
    KRD(GL, 1); GAPB(o[1] = __builtin_amdgcn_mfma_f32_32x32x16_bf16(PAF(1), VFR(5), o[1], 0, 0, 0), C0, 12); \
    KRD(GL, 2); GAPB(o[0] = __builtin_amdgcn_mfma_f32_32x32x16_bf16(PAF(2), VFR(2), o[0], 0, 0, 0), C1, 0); \
    KRD(GL, 3); GAPB(o[1] = __builtin_amdgcn_mfma_f32_32x32x16_bf16(PAF(2), VFR(6), o[1], 0, 0, 0), C1, 4); \
    GAPB(o[0] = __builtin_amdgcn_mfma_f32_32x32x16_bf16(PAF(3), VFR(3), o[0], 0, 0, 0), C1, 8); \
    GAPB(o[1] = __builtin_amdgcn_mfma_f32_32x32x16_bf16(PAF(3), VFR(7), o[1], 0, 0, 0), C1, 12); \
    } while (0)
  STEP(pB0, pB1, pA0, pA1, 1, true, true, true, false);  WAIT_BAR(2); RESC();
  STEP(pA0, pA1, pB0, pB1, 2, true, true, true, false);  WAIT_BAR(2); RESC();
  STEP(pB0, pB1, pA0, pA1, 3, true, true, true, false);  WAIT_BAR(2); RESC();
  STEP(pA0, pA1, pB0, pB1, 4, true, true, true, false);  WAIT_BAR(2); RESC();
  STEP(pB0, pB1, pA0, pA1, 5, true, true, true, false);  WAIT_BAR(2); RESC();
  STEP(pA0, pA1, pB0, pB1, 6, false, true, true, false); WAIT_BAR(1); RESC();
  STEP(pB0, pB1, pA0, pA1, 7, false, true, true, false); WAIT_BAR(0); RESC();
  STEP(pA0, pA1, pB0, pB1, 8, false, false, false, false); RESC();
  const bf16* Gw = GG + (rowbase + q0 + wid * QBLK) * DMP + hc * 64;
  u32x4 gq[4];
#pragma unroll
  for (int i = 0; i < 4; ++i) gq[i] = *(const u32x4*)(Gw + (long)(i * 8 + (lane >> 3)) * DMP + (lane & 7) * 8);
  { float sacc = pA0[0] + pA0[1]; _Pragma("unroll") for (int r = 2; r < 16; ++r) sacc += pA0[r]; _Pragma("unroll") for (int r = 0; r < 16; ++r) sacc += pA1[r]; l_reg += sacc;
    pw0 = (u32x4){PKW(pA0, 0), PKW(pA0, 2), PKW(pA0, 4), PKW(pA0, 6)}; pw1 = (u32x4){PKW(pA0, 8), PKW(pA0, 10), PKW(pA0, 12), PKW(pA0, 14)}; pw2 = (u32x4){PKW(pA1, 0), PKW(pA1, 2), PKW(pA1, 4), PKW(pA1, 6)}; pw3 = (u32x4){PKW(pA1, 8), PKW(pA1, 10), PKW(pA1, 12), PKW(pA1, 14)};
    SBAR(); pv(o, vb0 + SLW(8), PAF(0), PAF(1), PAF(2), PAF(3)); }
  if (fetch_next) {
    asm volatile("s_waitcnt lgkmcnt(0)\n\ts_barrier" ::: "memory");
#define TLN(n) (g0 + 4 + (n) > 0 ? g0 + 4 + (n) : 0)
#define DMA_KN(n) glds16(ksrc + (long)TLN(n) * KVBLK * DMP, (unsigned)__builtin_amdgcn_readfirstlane(kdst + SLOT(n)))
#define DMA_VN(n) glds16(vsrc + (long)TLN(n) * KVBLK * DMP, (unsigned)__builtin_amdgcn_readfirstlane(vdst + SLOT(n)))
    DMA_KN(0); DMA_VN(0); DMA_KN(1); DMA_VN(1); DMA_KN(2); DMA_VN(2); DMA_KN(3); DMA_VN(3); DMA_KN(4); DMA_KN(5);
#undef TLN
#undef DMA_KN
#undef DMA_VN
  }
#undef PKW
#undef PAF
#undef VFR
#undef PIN
#undef MX3
#undef GAPA
#undef GAPB
#undef EX
#undef VRD
#undef KRD
#undef STEP
#undef ENDW
#undef WAITS
  { auto rr = __builtin_amdgcn_permlane32_swap(__float_as_uint(l_reg), __float_as_uint(l_reg), false, false); l_reg = __uint_as_float(rr[0]) + __uint_as_float(rr[1]); }
  if (hi == 0) wsf[32 + r32] = l_reg; asm volatile("s_waitcnt lgkmcnt(0)" ::: "memory");
  float rli[16];
#pragma unroll
  for (int r = 0; r < 16; ++r) rli[r] = __builtin_amdgcn_rcpf(wsf[32 + crow(r, hi)]);
#if defined(REP_PHASE)
  int oalt_ = P.o_alt; asm volatile("" : "+s"(oalt_));
  bf16* Ow = (oalt_ ? (bf16*)(P.ws + WS_Y) : Q) + (rowbase + q0 + wid * QBLK) * DMP + hc * 64;
#else
  bf16* Ow = Q + (rowbase + q0 + wid * QBLK) * DMP + hc * 64;
#endif
  { bf16* stg = (bf16*)(shm + B_OST) + wid * 2048;
#pragma unroll
    for (int r = 0; r < 16; ++r) { const int orow = crow(r, hi);
#pragma unroll
      for (int d0 = 0; d0 < 2; ++d0) stg[orow * 64 + d0 * 32 + r32] = (bf16)f2bf(o[d0][r] * rli[r]); }
    asm volatile("s_waitcnt lgkmcnt(0)" ::: "memory");
#pragma unroll
    for (int i = 0; i < 4; ++i) { const int row = i * 8 + (lane >> 3), ch = lane & 7; const u32x4 v = *(const u32x4*)(stg + row * 64 + ch * 8);
      u32x4 w;
#pragma unroll
      for (int k = 0; k < 4; ++k) { const float g0 = bf2f(gq[i][k] & 0xFFFFu), g1 = bf2f(gq[i][k] >> 16);
        const float a0 = bf2f(v[k] & 0xFFFFu) * g0 * __builtin_amdgcn_rcpf(1.f + __expf(-g0)), a1 = bf2f(v[k] >> 16) * g1 * __builtin_amdgcn_rcpf(1.f + __expf(-g1)); w[k] = pk2(a0, a1); }
      *(u32x4*)(Ow + (long)row * DMP + ch * 8) = w; } }
  if (fetch_next) {
    const char* Qn = (const char*)(Q + (rowbase + q0 + QB + wid * QBLK) * DMP + hc * 64);
    int l2 = lane; asm volatile("" : "+v"(l2));
    const unsigned qo = (unsigned)((l2 & 31) * DMP + (l2 >> 5) * 8) * 2u;
#pragma unroll
    for (int d0 = 0; d0 < 4; ++d0) qpre[d0] = *reinterpret_cast<const bf16x8*>(Qn + qo + d0 * 32); }
  else {
#pragma unroll
    for (int d0 = 0; d0 < 4; ++d0) qpre[d0] = bf16x8{}; }
  asm volatile("s_waitcnt vmcnt(0) lgkmcnt(0)\n\ts_barrier" ::: "memory");
#undef DMA_K
#undef DMA_V
#undef DMA_M
#undef MROT
#undef CMASK
#undef START
#undef RESC
#undef ROT
#undef TL
#undef SLOT
#undef SLW
#undef QLD
}

#undef SBAR
#undef WAIT_BAR
}

__device__ __forceinline__ void p6_norm(const Prm& P, int vcu, int G, bool grp) {
    const int tid = opaque_tid(), lane = tid & 63, wave = tid >> 6, gw = vcu * NWAVES + wave, NGW = G * NWAVES;
    const bf16* Y = (const bf16*)(P.ws + WS_Y); bf16* H = (bf16*)(P.ws + WS_H); float* RS1 = (float*)(P.ws + WS_FLG);
    const int rb = grp ? 8192 * (vcu >> 5) : 0, Ml = grp ? 8192 : M, gwl = grp ? (vcu & 31) * NWAVES + wave : gw, NGl = grp ? 32 * NWAVES : NGW;
    for (int ml = gwl; ml < Ml; ml += 2 * NGl) {
        int mr[2]; mr[0] = rb + ml; mr[1] = ml + NGl < Ml ? rb + ml + NGl : rb + ml;
        const f32x4* pg = (const f32x4*)P.post_g + lane;
        unsigned long long yw[2][4]; f32x4 xv[2][4], pgv[4];
#pragma unroll
        for (int i = 0; i < 2; ++i) { const unsigned long long* yr = (const unsigned long long*)(Y + (size_t)mr[i] * DM) + lane; const f32x4* xr = (const f32x4*)(P.x + (size_t)mr[i] * DM) + lane;
#pragma unroll
            for (int j = 0; j < 4; ++j) { yw[i][j] = yr[64 * j]; xv[i][j] = xr[64 * j]; } }
#pragma unroll
        for (int j = 0; j < 4; ++j) pgv[j] = pg[64 * j];
#pragma unroll
        for (int i = 0; i < 2; ++i) {
            f32x4 y[4]; float s = 0.f;
#pragma unroll
            for (int j = 0; j < 4; ++j) { const unsigned long long w = yw[i][j]; y[j] = (f32x4){bf2f((unsigned)w & 0xFFFFu), bf2f(((unsigned)w) >> 16), bf2f((unsigned)(w >> 32) & 0xFFFFu), bf2f((unsigned)(w >> 48))};
                s += (y[j].x * y[j].x + y[j].y * y[j].y) + (y[j].z * y[j].z + y[j].w * y[j].w); }
            const float rs = 1.0f / sqrtf(wave_sum(s) * (1.f / DM) + RMS_EPS);
            float s2 = 0.f;
#pragma unroll
            for (int j = 0; j < 4; ++j) { y[j] = xv[i][j] + y[j] * rs * pgv[j]; s2 += (y[j].x * y[j].x + y[j].y * y[j].y) + (y[j].z * y[j].z + y[j].w * y[j].w); }
            const float rs2 = 1.0f / sqrtf(wave_sum(s2) * (1.f / DM) + RMS_EPS);
            unsigned long long* hr = (unsigned long long*)(H + (size_t)mr[i] * DM) + lane;
#pragma unroll
            for (int j = 0; j < 4; ++j) hr[64 * j] = (unsigned long long)pk2(y[j].x, y[j].y) | ((unsigned long long)pk2(y[j].z, y[j].w) << 32);
            if (lane == 0) RS1[(size_t)mr[i] * 8] = rs2; }
    }
}
__device__ __forceinline__ void p10_final(const Prm& P, int vcu, int G, bool grp) {
    const int tid = opaque_tid(), lane = tid & 63, wave = tid >> 6, gw = vcu * NWAVES + wave, NGW = G * NWAVES;
    const bf16* Y = (const bf16*)(P.ws + WS_Y); const bf16* H = (const bf16*)(P.ws + WS_H);
    const int rb = grp ? 8192 * (vcu >> 5) : 0, Ml = grp ? 8192 : M, gwl = grp ? (vcu & 31) * NWAVES + wave : gw, NGl = grp ? 32 * NWAVES : NGW;
    for (int ml = gwl; ml < Ml; ml += 2 * NGl) {
        int mr[2]; mr[0] = rb + ml; mr[1] = ml + NGl < Ml ? rb + ml + NGl : rb + ml;
        const f32x4* pg = (const f32x4*)(P.post_g + DM) + lane;
        unsigned long long yw[2][4], hw[2][4]; f32x4 pgv[4];
#pragma unroll
        for (int i = 0; i < 2; ++i) { const unsigned long long* yr = (const unsigned long long*)(Y + (size_t)mr[i] * DM) + lane; const unsigned long long* hr = (const unsigned long long*)(H + (size_t)mr[i] * DM) + lane;
#pragma unroll
            for (int j = 0; j < 4; ++j) { yw[i][j] = yr[64 * j]; hw[i][j] = hr[64 * j]; } }
#pragma unroll
        for (int j = 0; j < 4; ++j) pgv[j] = pg[64 * j];
#pragma unroll
        for (int i = 0; i < 2; ++i) {
            f32x4* orow = (f32x4*)(P.out + (size_t)mr[i] * DM) + lane;
            f32x4 y[4]; float s = 0.f;
#pragma unroll
            for (int j = 0; j < 4; ++j) { const unsigned long long w = yw[i][j]; y[j] = (f32x4){bf2f((unsigned)w & 0xFFFFu), bf2f(((unsigned)w) >> 16), bf2f((unsigned)(w >> 32) & 0xFFFFu), bf2f((unsigned)(w >> 48))};
                s += (y[j].x * y[j].x + y[j].y * y[j].y) + (y[j].z * y[j].z + y[j].w * y[j].w); }
            const float rs = 1.0f / sqrtf(wave_sum(s) * (1.f / DM) + RMS_EPS);
#pragma unroll
            for (int j = 0; j < 4; ++j) { const unsigned long long w = hw[i][j]; const f32x4 x1 = (f32x4){bf2f((unsigned)w & 0xFFFFu), bf2f(((unsigned)w) >> 16), bf2f((unsigned)(w >> 32) & 0xFFFFu), bf2f((unsigned)(w >> 48))};
                orow[64 * j] = x1 + y[j] * rs * pgv[j]; } }
    }
}

constexpr int CW_BAR = 4096;
constexpr int CW_MISMATCH = 3072;
#define XB_TMO      128
#define XB_XCNT(j)  (256  + 64 * (j))
#define XB_XSUB(j)  (1280 + 64 * (j))
#define XB_XGEN(j)  (2304 + 64 * (j))
#define XB_TOP      3328
#define XB_TOPGEN   3392
#define XCD_BAR_WORDS 3456
#define XB_SPIN_CAP (1u << 18)

__device__ __forceinline__ unsigned xb_ld(unsigned* p)              { return __hip_atomic_load(p, __ATOMIC_RELAXED, __HIP_MEMORY_SCOPE_AGENT); }
__device__ __forceinline__ unsigned xb_add(unsigned* p, unsigned v) { return __hip_atomic_fetch_add(p, v, __ATOMIC_RELAXED, __HIP_MEMORY_SCOPE_AGENT); }
__device__ __forceinline__ unsigned xb_xcc_id() { return (unsigned)__builtin_amdgcn_s_getreg((3 << 11) | 20) & 0xFu; }
#define XB_SPIN(cond, bar) do { unsigned _sp = 0; while (cond) { __builtin_amdgcn_s_sleep(1); \
    if ((++_sp & 255u) == 0u) { if (xb_ld(&(bar)[XB_TMO])) break; if (_sp > XB_SPIN_CAP) { atomicAdd(&(bar)[XB_TMO], 1u); break; } } } } while (0)

struct XcdBarrier {
    unsigned* bar; unsigned x;
    volatile LAS unsigned* st;
};

__device__ __forceinline__ XcdBarrier xcd_barrier_post(unsigned* bar, volatile LAS unsigned* st) {
    XcdBarrier b; b.bar = bar; b.x = xb_xcc_id(); b.st = st;
    if (threadIdx.x == 0) (void)xb_add(&bar[XB_XCNT(b.x)], 1u);
    return b;
}
__device__ __forceinline__ void xcd_barrier_complete(unsigned* bar, unsigned x, unsigned& nloc, unsigned& nx) {
    const unsigned G = gridDim.x * gridDim.y * gridDim.z;
    unsigned sum, cnt, mine, sp = 0u;
    for (;;) {
        sum = 0u; cnt = 0u; mine = 0u;
#pragma unroll
        for (unsigned j = 0; j < 16; ++j) { const unsigned c = xb_ld(&bar[XB_XCNT(j)]); sum += c; cnt += (c > 0u) ? 1u : 0u; mine = (j == x) ? c : mine; }
        if (sum == G) break;
        __builtin_amdgcn_s_sleep(1);
        if ((++sp & 255u) == 0u) { if (xb_ld(&bar[XB_TMO])) break; if (sp > XB_SPIN_CAP) { atomicAdd(&bar[XB_TMO], 1u); break; } }
    }
    nloc = mine > 0u ? mine : 1u; nx = cnt > 0u ? cnt : 1u;
}

__device__ __forceinline__ void xcd_barrier(const XcdBarrier& b, bool local = false) {
    asm volatile("s_waitcnt vmcnt(0)" ::: "memory");
    __syncthreads();
    if (threadIdx.x == 0) {
        unsigned* bar = b.bar;
        __builtin_amdgcn_s_waitcnt(0);
        unsigned nloc = b.st[0], nx = b.st[1];
        if (nloc == 0u) { xcd_barrier_complete(bar, b.x, nloc, nx); b.st[0] = nloc; b.st[1] = nx; }
        const unsigned old = xb_add(&bar[XB_XSUB(b.x)], 1u);
        const unsigned gen = old / nloc;
        if (old + 1u == (gen + 1u) * nloc) {
          if (!local) {
            __builtin_amdgcn_fence(__ATOMIC_RELEASE, "agent");
            asm volatile("s_waitcnt vmcnt(0)" ::: "memory");
            const unsigned og = xb_add(&bar[XB_TOP], 1u);
            const unsigned tg = og / nx;
            if (og + 1u == (tg + 1u) * nx) xb_add(&bar[XB_TOPGEN], 1u);
            else XB_SPIN(xb_ld(&bar[XB_TOPGEN]) == tg, bar);
          }
            __builtin_amdgcn_fence(__ATOMIC_ACQUIRE, "agent");
            xb_add(&bar[XB_XGEN(b.x)], 1u);
            asm volatile("s_waitcnt vmcnt(0)" ::: "memory");
        } else {
            XB_SPIN(xb_ld(&bar[XB_XGEN(b.x)]) == gen, bar);
            __builtin_amdgcn_fence(__ATOMIC_ACQUIRE, "agent");
            asm volatile("s_waitcnt vmcnt(0)" ::: "memory");
        }
    }
    __syncthreads();
}

constexpr int NPHASE = 11;
__global__ void __launch_bounds__(NTHR, 2) fwd(Prm P) {
    extern __shared__ __attribute__((aligned(16))) unsigned char lds_raw[];
    LAS unsigned char* lds = (LAS unsigned char*)lds_raw;
    const int G = gridDim.x, bx = blockIdx.x;
    const int vcu = (G % 8 == 0) ? (bx % 8) * (G / 8) + bx / 8 : bx;
    const int lo = P.ph_lo, hi = P.ph_hi;
    unsigned char* ws = P.ws;
    if (threadIdx.x < 64) ((LAS unsigned*)(lds + MISC_OFF))[threadIdx.x] = 0u;
    __syncthreads();
    XcdBarrier bar; bar.bar = (unsigned*)(ws + WS_CTL) + CW_BAR + P.li * XCD_BAR_WORDS; bar.x = 0; bar.st = nullptr;
    if (hi - lo > 1) bar = xcd_barrier_post((unsigned*)(ws + WS_CTL) + CW_BAR + P.li * XCD_BAR_WORDS, (volatile LAS unsigned*)(lds + MISC_OFF));
#define IN(k) (lo <= (k) && (k) < hi)
#define SEAM(k) do { if (IN(k) && IN((k) + 1)) xcd_barrier(bar, (k) >= 1 && use_local); } while (0)
    bool use_local = false;
    unsigned* mis = (unsigned*)(ws + WS_CTL) + CW_MISMATCH;
    if (G == 256 && IN(0) && IN(1) && threadIdx.x == 0 && bar.x != (unsigned)(bx & 7)) (void)__hip_atomic_fetch_or(mis, 1u, __ATOMIC_RELAXED, __HIP_MEMORY_SCOPE_AGENT);
    if (IN(0)) p0_prologue(P, lds, vcu, G);
    SEAM(0);
    if (G == 256 && IN(0) && IN(1)) use_local = __hip_atomic_load(mis, __ATOMIC_RELAXED, __HIP_MEMORY_SCOPE_AGENT) == 0u;
#if defined(FORCE_GRID_BARRIERS)
    use_local = false;
#endif
    if (IN(1)) {
        pg8::Gemm g{(const pg8::bf16_t*)(ws + WS_H), (const pg8::bf16_t*)(ws + WS_W0T), M, N0, 1024}; pg8::StaticOrder S; S.init(M, N0, G, bx); pg8::EpiProj<false> E{ws, P.b_forget, 0, 0, nullptr};
        pg8::gemm_phase<pg8::EpiProj<false>, pg8::StaticOrder, true, true>(lds, g, S, E);
    }
    SEAM(1);
    if (IN(2)) p2_post(P, lds, vcu, G, use_local);
    SEAM(2);
    if (IN(3)) p3_indexer(P, lds, vcu, G, use_local);
    SEAM(3);
    if (IN(4)) {
        if (G == 256) {
            unsigned* ctr = (unsigned*)(ws + WS_CTL) + CW_QUEUE + 64 * (vcu >> 4); LAS int* qslot = (LAS int*)(lds + MISC_OFF + 64);
            int nxt = 0; if (threadIdx.x == 0) nxt = (int)__hip_atomic_fetch_add(ctr, 1u, __ATOMIC_RELAXED, __HIP_MEMORY_SCOPE_AGENT);
            bool fet = false; bf16x8 qpre[4]; f32x4 cpre0, cpre1, cpre2, cpre3;
            LAS float* kmt = (LAS float*)(lds + af::LDS_VOTE + 32);
            if (threadIdx.x < 8) kmt[threadIdx.x] = __uint_as_float(__hip_atomic_load((const unsigned*)(ws + WS_CTL) + CW_KMAX + (vcu >> 4) * 8 + threadIdx.x, __ATOMIC_RELAXED, __HIP_MEMORY_SCOPE_AGENT));
            for (;;) {
                if (threadIdx.x == 0) *qslot = nxt;
                __syncthreads();
                const int cur = *qslot;
                if (cur >= 128) break;
                if (threadIdx.x == 0) nxt = (int)__hip_atomic_fetch_add(ctr, 1u, __ATOMIC_RELAXED, __HIP_MEMORY_SCOPE_AGENT);
                af::attn_unit<0, 8>(P, (char*)lds_raw, vcu >> 4, cur & 7, 15 - (cur >> 3), qpre, cpre0, cpre1, cpre2, cpre3, fet, 2, nxt, qslot + 1, kmt); fet = true;
            }
            __syncthreads();
        }
        else { bf16x8 qpre[4]; f32x4 cpre0, cpre1, cpre2, cpre3; for (int u0 = vcu; u0 < NB * 8 * 16; u0 += G) af::attn_unit<0, 8>(P, (char*)lds_raw, u0 >> 7, (u0 >> 4) & 7, u0 & 15, qpre, cpre0, cpre1, cpre2, cpre3); }
        if (G == 256) { bf16x8 qpre[4]; f32x4 cpre0, cpre1, cpre2, cpre3; for (int i = 0; i < 8; ++i) { const int bh = vcu >> 1, sidx = 4 * (vcu & 1) + (i >> 1), qb = (i & 1) ? 15 - sidx : sidx, sn = 4 * (vcu & 1) + ((i + 1) >> 1), qn = i == 7 ? -1 : ((i + 1) & 1) ? 15 - sn : sn;
            af::attn_unit<1, 8>(P, (char*)lds_raw, bh >> 3, 8 + (bh & 7), qb, qpre, cpre0, cpre1, cpre2, cpre3, i > 0, 1, qn); } }
        else { bf16x8 qpre[4]; f32x4 cpre0, cpre1, cpre2, cpre3; for (int u0 = vcu; u0 < NB * 8 * 16; u0 += G) af::attn_unit<1, 8>(P, (char*)lds_raw, u0 >> 7, 8 + ((u0 >> 4) & 7), u0 & 15, qpre, cpre0, cpre1, cpre2, cpre3); }
    }
    SEAM(4);
    if (IN(5)) { pg8::Gemm g{(const pg8::bf16_t*)(ws + WS_QQ), (const pg8::bf16_t*)(ws + WS_WO0T), M, 1024, 1024}; pg8::StaticOrder S; S.init(M, 1024, G, bx); pg8::EpiYb E{(pg8::bf16_t*)(ws + WS_Y)};
        pg8::gemm_phase<pg8::EpiYb, pg8::StaticOrder, true, true>(lds, g, S, E); }
    SEAM(5);
    if (IN(6)) p6_norm(P, vcu, G, use_local);
    SEAM(6);
    if (IN(7)) { pg8::Gemm g{(const pg8::bf16_t*)(ws + WS_H), (const pg8::bf16_t*)(ws + WS_W1T), M, N1, 1024}; pg8::StaticOrder S; S.init(M, N1, G, bx); pg8::EpiProj<false> E{ws, nullptr, 0, 0, (const float*)(ws + WS_FLG)};
        pg8::gemm_phase<pg8::EpiProj<false>, pg8::StaticOrder, true, true>(lds, g, S, E); }
    SEAM(7);
    if (IN(8)) {
        if (G == 256) { bf16x8 qpre[4]; for (int qb = 0; qb < 16; ++qb) af::attn_band_unit(P, (char*)lds_raw, vcu >> 4, vcu & 15, qb, qpre, qb > 0, qb < 15); }
        else { bf16x8 qpre[4]; f32x4 cpre0, cpre1, cpre2, cpre3; for (int u0 = vcu; u0 < NB * 16 * 16; u0 += G) af::attn_unit<2, 8>(P, (char*)lds_raw, u0 >> 8, (u0 >> 4) & 15, u0 & 15, qpre, cpre0, cpre1, cpre2, cpre3); }
    }
    SEAM(8);
    if (IN(9)) { pg8::Gemm g{(const pg8::bf16_t*)(ws + WS_QQ), (const pg8::bf16_t*)(ws + WS_WO1T), M, 1024, 1024}; pg8::StaticOrder S; S.init(M, 1024, G, bx); pg8::EpiYb E{(pg8::bf16_t*)(ws + WS_Y)};
        pg8::gemm_phase<pg8::EpiYb, pg8::StaticOrder, true, true>(lds, g, S, E); }
    SEAM(9);
    if (IN(10)) p10_final(P, vcu, G, use_local);
#undef IN
#undef SEAM
}

extern "C" void kernel_launch(void* const* d_in, const int* in_sizes, int n_in, void* d_out, int out_size, void* d_ws, size_t ws_size, hipStream_t stream) {
    static int grid = 0;
    if (grid == 0) {
        if (n_in != 12 || in_sizes[0] != M * DM || out_size != M * DM || ws_size < WS_END) { fprintf(stderr, "kernel_launch: unexpected shapes (n_in %d, ws %zu)\n", n_in, ws_size); grid = -1; return; }
        int dev = 0, cus = 0;
        if (hipGetDevice(&dev) != hipSuccess || hipDeviceGetAttribute(&cus, hipDeviceAttributeMultiprocessorCount, dev) != hipSuccess) { grid = -1; return; }
        if (hipFuncSetAttribute((const void*)fwd, hipFuncAttributeMaxDynamicSharedMemorySize, LDS_BYTES) != hipSuccess) { grid = -1; return; }
        grid = cus;
    }
    if (grid < 0) return;
    Prm p{};
    p.x = (const float*)d_in[0]; p.pos = (const int*)d_in[1]; p.pre_g = (const float*)d_in[2]; p.post_g = (const float*)d_in[3]; p.w_in0 = (const float*)d_in[4];
    p.b_forget = (const float*)d_in[5]; p.ikg = (const float*)d_in[6]; p.ikb = (const float*)d_in[7]; p.w_out0 = (const float*)d_in[8]; p.w_in1 = (const float*)d_in[9];
    p.rel = (const float*)d_in[10]; p.w_out1 = (const float*)d_in[11];
    p.out = (float*)d_out; p.ws = (unsigned char*)d_ws;
    if (hipMemsetAsync((char*)d_ws + WS_CTL, 0, CTL_ZERO_BYTES, stream) != hipSuccess) return;
#if defined(MK_PER_PHASE)
    for (int ph = 0; ph < NPHASE; ++ph) { p.ph_lo = ph; p.ph_hi = ph + 1; hipLaunchKernelGGL(fwd, dim3(grid), dim3(NTHR), LDS_BYTES, stream, p); }
#elif defined(REP_PHASE)
    { const bool attn = (REP_PHASE == 4 || REP_PHASE == 8);
      p.ph_lo = 0; p.ph_hi = attn ? REP_PHASE : REP_PHASE + 1; p.li = 0; hipLaunchKernelGGL(fwd, dim3(grid), dim3(NTHR), LDS_BYTES, stream, p);
      p.ph_lo = REP_PHASE; p.ph_hi = REP_PHASE + 1; p.li = 1; p.o_alt = attn ? 1 : 0; hipLaunchKernelGGL(fwd, dim3(grid), dim3(NTHR), LDS_BYTES, stream, p); p.o_alt = 0;
      p.ph_lo = attn ? REP_PHASE : REP_PHASE + 1; p.ph_hi = NPHASE; p.li = 2; if (p.ph_lo < NPHASE) hipLaunchKernelGGL(fwd, dim3(grid), dim3(NTHR), LDS_BYTES, stream, p); }
#else
    p.ph_lo = 0; p.ph_hi = NPHASE;
    hipLaunchKernelGGL(fwd, dim3(grid), dim3(NTHR), LDS_BYTES, stream, p);
#endif
}
```
